# Optimizing an MI355X kernel written in HIP

```python
import math
import jax, jax.numpy as jnp
from jax import lax
import numpy as np

D_MODEL = 1024
BATCH = 16
SEQ = 2048
DEPTH = 2

N_A_LAYERS = DEPTH // 2
N_B_LAYERS = DEPTH - N_A_LAYERS
N_HEADS = 16
HEAD_DIM = D_MODEL // N_HEADS
Q_BLOCK = 128
CONV_WIDTH = 31
N_EXPERTS = 32
TOP_K = 4
D_FF = D_MODEL
SWIGLU_LIMIT = 7.0
SWIGLU_ALPHA = 1.702
MOE_BLOCK = 128
ALPHA_DN = (2.0 * DEPTH) ** 0.25
BETA_DN = (8.0 * DEPTH) ** -0.25
LN_EPS = 1e-5

kernel_name = "yoco_conformer_stickbreaking_moe_adaln"


def layer_norm(x, g, b):
    xf = x.astype(jnp.float32)
    mu = jnp.mean(xf, axis=-1, keepdims=True)
    var = jnp.mean(jnp.square(xf - mu), axis=-1, keepdims=True)
    y = (xf - mu) * lax.rsqrt(var + LN_EPS) * g.astype(jnp.float32) + b.astype(jnp.float32)
    return y.astype(x.dtype)


def modulate(x, shift, scale):
    return x * (1.0 + scale[:, None, :]) + shift[:, None, :]


def conformer_conv(h, w1, b1, dw, db, lg, lb, w2, b2):
    u = h @ w1 + b1
    a, g = jnp.split(u, 2, axis=-1)
    u = a * jax.nn.sigmoid(g)
    u = lax.conv_general_dilated(
        u, dw[:, None, :], window_strides=(1,), padding=[(CONV_WIDTH - 1, 0)],
        dimension_numbers=('NWC', 'WIO', 'NWC'), feature_group_count=D_MODEL) + db
    u = jax.nn.silu(layer_norm(u, lg, lb))
    return u @ w2 + b2


def stick_breaking_attention(h, q_w, k, v, o_w):
    B, L, _ = h.shape
    q = (h @ q_w).reshape(B, L, N_HEADS, HEAD_DIM).transpose(0, 2, 1, 3)
    scale = HEAD_DIM ** -0.5
    outs = []
    for i in range(L // Q_BLOCK):
        t0, end = i * Q_BLOCK, (i + 1) * Q_BLOCK
        qb = q[:, :, t0:end]
        kb, vb = k[:, :, :end], v[:, :, :end]
        z = jnp.einsum('bhtd,bhsd->bhts', qb, kb).astype(jnp.float32) * scale
        t_pos = t0 + jnp.arange(Q_BLOCK)[:, None]
        s_pos = jnp.arange(end)[None, :]
        causal = s_pos < t_pos
        log_om = jnp.where(causal, jax.nn.log_sigmoid(-z), 0.0)
        suffix = lax.cumsum(log_om, axis=3, reverse=True) - log_om
        log_a = jax.nn.log_sigmoid(z) + suffix
        a = jnp.where(causal, jnp.exp(log_a), 0.0)
        outs.append(jnp.einsum('bhts,bhsd->bhtd', a.astype(vb.dtype), vb))
    o = jnp.concatenate(outs, axis=2)
    o = o.transpose(0, 2, 1, 3).reshape(B, L, D_MODEL)
    return o @ o_w


def clamped_swiglu(u):
    x_glu, x_lin = jnp.split(u, 2, axis=-1)
    x_glu = jnp.minimum(x_glu, SWIGLU_LIMIT)
    x_lin = jnp.clip(x_lin, -SWIGLU_LIMIT, SWIGLU_LIMIT)
    return (x_lin + 1.0) * (x_glu * jax.nn.sigmoid(SWIGLU_ALPHA * x_glu))


def moe(h, router_w, router_b, w_in, b_in, w_out, b_out):
    B, L, D = h.shape
    T = B * L
    A = T * TOP_K
    xt = h.reshape(T, D)
    logits = (xt @ router_w + router_b).astype(jnp.float32)
    top_val, top_idx = lax.top_k(logits, TOP_K)
    gates = jax.nn.softmax(top_val, axis=-1).astype(h.dtype)
    flat_e = top_idx.reshape(A).astype(jnp.int32)
    flat_tok = jnp.arange(A, dtype=jnp.int32) // TOP_K
    flat_g = gates.reshape(A)
    order = jnp.argsort(flat_e, stable=True)
    s_e, s_tok, s_g = flat_e[order], flat_tok[order], flat_g[order]
    counts = jnp.bincount(flat_e, length=N_EXPERTS).astype(jnp.int32)
    starts = jnp.cumsum(counts) - counts
    padded = ((counts + MOE_BLOCK - 1) // MOE_BLOCK) * MOE_BLOCK
    pend = jnp.cumsum(padded)
    pstart = pend - padded
    dest = pstart[s_e] + (jnp.arange(A, dtype=jnp.int32) - starts[s_e])
    n_blocks = -(-A // MOE_BLOCK) + N_EXPERTS
    R = n_blocks * MOE_BLOCK
    row_tok = jnp.zeros((R,), jnp.int32).at[dest].set(s_tok)
    row_g = jnp.zeros((R,), h.dtype).at[dest].set(s_g)
    block_start = jnp.arange(n_blocks, dtype=jnp.int32) * MOE_BLOCK
    block_e = jnp.minimum(jnp.searchsorted(pend, block_start, side='right'),
                          N_EXPERTS - 1).astype(jnp.int32)

    def expert_block(args):
        e, tok, g = args
        xe = xt[tok]
        u = xe @ w_in[e] + b_in[e]
        y = clamped_swiglu(u) @ w_out[e] + b_out[e]
        return y * g[:, None]

    yb = lax.map(expert_block, (block_e, row_tok.reshape(n_blocks, MOE_BLOCK),
                                row_g.reshape(n_blocks, MOE_BLOCK)))
    out = jnp.zeros((T, D), h.dtype).at[row_tok].add(yb.reshape(R, D))
    return out.reshape(B, L, D)


def setup_inputs(seed: int = 0) -> dict:
    key = jax.random.key(seed)
    ks = jax.random.split(key, 26)
    D, E, F = D_MODEL, N_EXPERTS, D_FF
    nrm = lambda k, s: jax.random.normal(k, s, jnp.float32)
    inv = D ** -0.5
    k_part = nrm(ks[13], (D, D)) * inv
    v_part = nrm(ks[14], (D, D)) * inv * BETA_DN
    return {
        "x": nrm(ks[0], (BATCH, SEQ, D)),
        "c": nrm(ks[1], (BATCH, D)),
        "ada_w": nrm(ks[2], (DEPTH, D, 6 * D)) * (0.1 * inv),
        "ada_b": 0.01 * nrm(ks[3], (DEPTH, 6 * D)),
        "ln_g": 1.0 + 0.01 * nrm(ks[4], (DEPTH, 2, D)),
        "ln_b": 0.01 * nrm(ks[5], (DEPTH, 2, D)),
        "cv_w1": nrm(ks[6], (N_A_LAYERS, D, 2 * D)) * inv,
        "cv_b1": 0.01 * nrm(ks[7], (N_A_LAYERS, 2 * D)),
        "cv_dw": nrm(ks[8], (N_A_LAYERS, CONV_WIDTH, D)) * CONV_WIDTH ** -0.5,
        "cv_db": 0.01 * nrm(ks[9], (N_A_LAYERS, D)),
        "cv_ln_g": 1.0 + 0.01 * nrm(ks[10], (N_A_LAYERS, D)),
        "cv_ln_b": 0.01 * nrm(ks[11], (N_A_LAYERS, D)),
        "cv_w2": nrm(ks[12], (N_A_LAYERS, D, D)) * inv * BETA_DN,
        "cv_b2": 0.01 * nrm(ks[15], (N_A_LAYERS, D)),
        "kv_w": jnp.concatenate([k_part, v_part], axis=1),
        "q_w": nrm(ks[16], (N_B_LAYERS, D, D)) * inv,
        "o_w": nrm(ks[17], (N_B_LAYERS, D, D)) * inv * BETA_DN,
        "router_w": nrm(ks[18], (DEPTH, D, E)) * inv,
        "router_b": 0.01 * nrm(ks[19], (DEPTH, E)),
        "moe_w_in": nrm(ks[20], (DEPTH, E, D, 2 * F)) * inv,
        "moe_b_in": 0.01 * nrm(ks[21], (DEPTH, E, 2 * F)),
        "moe_w_out": nrm(ks[22], (DEPTH, E, F, D)) * (F ** -0.5) * BETA_DN,
        "moe_b_out": 0.01 * nrm(ks[23], (DEPTH, E, D)),
    }


def reference(x, c, ada_w, ada_b, ln_g, ln_b, cv_w1, cv_b1, cv_dw, cv_db,
              cv_ln_g, cv_ln_b, cv_w2, cv_b2, kv_w, q_w, o_w, router_w,
              router_b, moe_w_in, moe_b_in, moe_w_out, moe_b_out):
    B, L, D = x.shape
    c_act = jax.nn.silu(c)
    k = v = None
    for l in range(DEPTH):
        mod = c_act @ ada_w[l] + ada_b[l]
        sh1, sc1, g1, sh2, sc2, g2 = jnp.split(mod, 6, axis=-1)
        h = modulate(x, sh1, sc1)
        if l < N_A_LAYERS:
            y = conformer_conv(h, cv_w1[l], cv_b1[l], cv_dw[l], cv_db[l],
                               cv_ln_g[l], cv_ln_b[l], cv_w2[l], cv_b2[l])
        else:
            j = l - N_A_LAYERS
            y = stick_breaking_attention(h, q_w[j], k, v, o_w[j])
        x = layer_norm(ALPHA_DN * x + (1.0 + g1)[:, None, :] * y, ln_g[l, 0], ln_b[l, 0])
        h = modulate(x, sh2, sc2)
        y = moe(h, router_w[l], router_b[l], moe_w_in[l], moe_b_in[l],
                moe_w_out[l], moe_b_out[l])
        x = layer_norm(ALPHA_DN * x + (1.0 + g2)[:, None, :] * y, ln_g[l, 1], ln_b[l, 1])
        if l == N_A_LAYERS - 1:
            kv = x @ kv_w
            k, v = jnp.split(kv, 2, axis=-1)
            k = k.reshape(B, L, N_HEADS, HEAD_DIM).transpose(0, 2, 1, 3)
            v = v.reshape(B, L, N_HEADS, HEAD_DIM).transpose(0, 2, 1, 3)
    return x
```

```cpp
#include <hip/hip_runtime.h>
#include <cstdio>
#include <cstdint>
#include <cstring>

constexpr int T = 32768, D = 1024, NBATCH = 16, SEQ = 2048, NHEAD = 16, HDIM = 64, NE = 32, TOPK = 4, CONVW = 31;
constexpr int NASG = T * TOPK;
constexpr int APAD = NASG + NE * 256;
constexpr int MAXRU = APAD / 256;
constexpr float LN_EPS = 1e-5f;
constexpr float ALPHA_DN = 1.41421356237309515f;
constexpr float LOG2E = 1.4426950408889634f;

namespace pg8 {
#define PG8_LAS __attribute__((address_space(3)))
typedef unsigned short bf16_t;
typedef short bf16x8 __attribute__((ext_vector_type(8)));
typedef float f32x4 __attribute__((ext_vector_type(4)));
typedef unsigned u32x4 __attribute__((ext_vector_type(4)));
constexpr int BM = 256, BK = 64, HALF = 128, HTB = HALF * BK * 2  , STAGE_BYTES = 8 * HTB, NXCD = 8, WGM = 8;

__host__ __device__ __forceinline__ int lds_byte(int r, int c) { const int st = (r >> 4) * 2 + (c >> 5), rr = r & 15, cc = c & 31, ob = rr * 64 + cc * 2; return st * 1024 + (ob ^ (((ob >> 9) & 1) << 5)); }
__host__ __device__ __forceinline__ void stage_rc(int b, int& R, int& C) { const int st = b / 1024, sb = b % 1024, swz = sb ^ (((sb >> 9) & 1) << 5); R = (st >> 1) * 16 + swz / 64; C = (st & 1) * 32 + (swz % 64) / 2; }
__host__ __device__ __forceinline__ int perm32(int rho) { const int n = rho >> 4, i = rho & 15; return 8 * (i >> 2) + 4 * n + (i & 3); }

struct Unit { int pm, pn, e; };
struct Gemm { const bf16_t* A; const bf16_t* Bt; int K; size_t estride; };

struct StaticOrder {
    int nM, nN, nwg, G, c;
    __device__ void init(int M, int N, int G_, int c_) { nM = M / BM; nN = N / BM; nwg = nM * nN; G = G_; c = c_; }
    __device__ bool next(int i, Unit& u) const {
        const long L = (long)i * G + c; if (L >= nwg) return false;
        int wgid = (int)L; { const int q = nwg / NXCD, r = nwg % NXCD, xcd = wgid % NXCD, off = wgid / NXCD; wgid = (xcd < r ? xcd * (q + 1) : r * (q + 1) + (xcd - r) * q) + off; }
        const int nig = WGM * nN, gid = wgid / nig, fm = gid * WGM, gsz = (nM - fm) < WGM ? (nM - fm) : WGM;
        u.pm = fm + ((wgid % nig) % gsz); u.pn = (wgid % nig) / gsz; u.e = 0; return true;
    }
    __device__ __forceinline__ void a_ready(const Unit&) const {}
    __device__ __forceinline__ void done(const Unit&) const {}
};
struct MoeOrder {
    int nM, nN, nwg, G, c; const PG8_LAS int* ru2e;
    __device__ void init(int nM_, int nN_, int G_, int c_, const PG8_LAS int* t) { nM = nM_; nN = nN_; nwg = nM * nN; G = G_; c = c_; ru2e = t; }
    __device__ bool next(int i, Unit& u) const {
        const long L = (long)i * G + c; if (L >= nwg) return false;
        int wgid = (int)L; { const int q = nwg / NXCD, r = nwg % NXCD, xcd = wgid % NXCD, off = wgid / NXCD; wgid = (xcd < r ? xcd * (q + 1) : r * (q + 1) + (xcd - r) * q) + off; }
        const int nig = WGM * nN, gid = wgid / nig, fm = gid * WGM, gsz = (nM - fm) < WGM ? (nM - fm) : WGM;
        u.pm = fm + ((wgid % nig) % gsz); u.pn = (wgid % nig) / gsz; u.e = __builtin_amdgcn_readfirstlane(ru2e[u.pm]); return true;
    }
    __device__ __forceinline__ void a_ready(const Unit&) const {}
    __device__ __forceinline__ void done(const Unit&) const {}
};

typedef float f32x2_t __attribute__((ext_vector_type(2))); typedef __bf16 bf16x2_t __attribute__((ext_vector_type(2)));
__device__ __forceinline__ unsigned cvt_pk_bf16(float lo, float hi) { f32x2_t v = {lo, hi}; bf16x2_t b = __builtin_convertvector(v, bf16x2_t); return __builtin_bit_cast(unsigned, b); }
__device__ __forceinline__ float sigmoidf_(float x) { return __builtin_amdgcn_rcpf(1.0f + __builtin_amdgcn_exp2f(-x * LOG2E)); }

struct EpiBf16 {
    static constexpr bool PERM = true, AFTER_DRAIN = false;
    bf16_t* O; int ldc; float scale;
    __device__ __forceinline__ void operator()(const f32x4 (&acc)[2][2][4][2], const Unit& u, int wr, int wc, int fr, int fq) const {
        const int row0 = u.pm * BM + wr * 64 + fr, col0 = u.pn * BM + wc * 32 + 8 * fq;
#pragma unroll
        for (int ai = 0; ai < 2; ++ai)
#pragma unroll
            for (int m = 0; m < 4; ++m) { bf16_t* rowp = O + (size_t)(row0 + ai * HALF + m * 16) * ldc + col0;
#pragma unroll
                for (int bj = 0; bj < 2; ++bj) { const f32x4 v0 = acc[ai][bj][m][0] * scale, v1 = acc[ai][bj][m][1] * scale;
                    u32x4 w; w.x = cvt_pk_bf16(v0[0], v0[1]); w.y = cvt_pk_bf16(v0[2], v0[3]); w.z = cvt_pk_bf16(v1[0], v1[1]); w.w = cvt_pk_bf16(v1[2], v1[3]);
                    *(u32x4*)(rowp + bj * HALF) = w; } }
    }
};
template <int MODE> struct EpiGlu {
    static constexpr bool PERM = true, AFTER_DRAIN = false;
    bf16_t* O; const float* bias;
    __device__ __forceinline__ void operator()(const f32x4 (&acc)[2][2][4][2], const Unit& u, int wr, int wc, int fr, int fq) const {
        const int row0 = u.pm * BM + wr * 64 + fr, j0 = u.pn * HALF + wc * 32 + 8 * fq;
        const float* bp = bias + (size_t)u.e * 2048;
        f32x4 ba[2], bg[2];
#pragma unroll
        for (int n = 0; n < 2; ++n) { ba[n] = *(const f32x4*)(bp + j0 + 4 * n); bg[n] = *(const f32x4*)(bp + 1024 + j0 + 4 * n); }
#pragma unroll
        for (int ai = 0; ai < 2; ++ai)
#pragma unroll
            for (int m = 0; m < 4; ++m) { bf16_t* rowp = O + (size_t)(row0 + ai * HALF + m * 16) * 1024 + j0;
                float o[8];
#pragma unroll
                for (int n = 0; n < 2; ++n) { const f32x4 a = acc[ai][0][m][n] + ba[n], g = acc[ai][1][m][n] + bg[n];
#pragma unroll
                    for (int i = 0; i < 4; ++i) {
                        if (MODE == 0) o[4 * n + i] = a[i] * sigmoidf_(g[i]);
                        else { const float xg = fminf(a[i], 7.0f), xl = fminf(fmaxf(g[i], -7.0f), 7.0f); o[4 * n + i] = (xl + 1.0f) * (xg * sigmoidf_(1.702f * xg)); } } }
                u32x4 w; w.x = cvt_pk_bf16(o[0], o[1]); w.y = cvt_pk_bf16(o[2], o[3]); w.z = cvt_pk_bf16(o[4], o[5]); w.w = cvt_pk_bf16(o[6], o[7]);
                *(u32x4*)rowp = w; }
    }
};
struct EpiResid {
    static constexpr bool PERM = false, AFTER_DRAIN = false;
    const float* x; float* S; const float* bias; const float* gate;
    __device__ __forceinline__ void operator()(const f32x4 (&acc)[2][2][4][2], const Unit& u, int wr, int wc, int fr, int fq) const {
        const int col0 = u.pn * BM + wc * 32 + 4 * fq, b = (u.pm * BM) >> 11;
#pragma unroll
        for (int bj = 0; bj < 2; ++bj)
#pragma unroll
            for (int n = 0; n < 2; ++n) { const int c = col0 + bj * HALF + n * 16;
                const f32x4 bv = bias ? *(const f32x4*)(bias + c) : (f32x4){0.f, 0.f, 0.f, 0.f}; const f32x4 gv = *(const f32x4*)(gate + (size_t)b * 6144 + c) + 1.0f;
#pragma unroll
                for (int ai = 0; ai < 2; ++ai)
#pragma unroll
                    for (int m = 0; m < 4; ++m) { const size_t off = (size_t)(u.pm * BM + ai * HALF + wr * 64 + m * 16 + fr) * 1024 + c;
                        const f32x4 xv = *(const f32x4*)(x + off); *(f32x4*)(S + off) = xv * ALPHA_DN + gv * (acc[ai][bj][m][n] + bv); } }
    }
};
struct EpiMoeOut {
    static constexpr bool PERM = true, AFTER_DRAIN = false;
    bf16_t* Y; const float* bias; const int* row_asg; const float* row_gate;
    __device__ __forceinline__ void operator()(const f32x4 (&acc)[2][2][4][2], const Unit& u, int wr, int wc, int fr, int fq) const {
        const int row0 = u.pm * BM + wr * 64 + fr, col0 = u.pn * BM + wc * 32 + 8 * fq;
        const float* bp = bias + (size_t)u.e * 1024;
        f32x4 bv[2][2];
#pragma unroll
        for (int bj = 0; bj < 2; ++bj)
#pragma unroll
            for (int n = 0; n < 2; ++n) bv[bj][n] = *(const f32x4*)(bp + col0 + bj * HALF + 4 * n);
#pragma unroll
        for (int ai = 0; ai < 2; ++ai)
#pragma unroll
            for (int m = 0; m < 4; ++m) { const int r = row0 + ai * HALF + m * 16; const int dst = row_asg[r]; const float gt = row_gate[r];
                if (dst >= 0) { bf16_t* rowp = Y + (size_t)dst * 1024 + col0;
#pragma unroll
                    for (int bj = 0; bj < 2; ++bj) { const f32x4 v0 = (acc[ai][bj][m][0] + bv[bj][0]) * gt, v1 = (acc[ai][bj][m][1] + bv[bj][1]) * gt;
                        u32x4 w; w.x = cvt_pk_bf16(v0[0], v0[1]); w.y = cvt_pk_bf16(v0[2], v0[3]); w.z = cvt_pk_bf16(v1[0], v1[1]); w.w = cvt_pk_bf16(v1[2], v1[3]);
                        *(u32x4*)(rowp + bj * HALF) = w; } } }
    }
};

template <class Epi, class Sched, bool ALIGN_EPI = false, bool SP2 = false>
__device__ __forceinline__ void gemm_phase(PG8_LAS unsigned char* lds, const Gemm g, const Sched& S, const Epi& E) {
    int tid_l = threadIdx.x; asm volatile("" : "+v"(tid_l));
    const int tid = tid_l, wid = __builtin_amdgcn_readfirstlane(tid >> 6), lane = tid & 63, wr = wid >> 2, wc = wid & 3, fr = lane & 15, fq = lane >> 4;
    const int K = g.K, nt = K / BK;
    unsigned voffA[2], voffB[2];
#pragma unroll
    for (int i = 0; i < 2; ++i) { int R, C; stage_rc(tid * 16 + i * 8192, R, C); const int Rb = Epi::PERM ? ((R & ~31) + perm32(R & 31)) : R;
        voffA[i] = (unsigned)(R * K + C) * 2u; voffB[i] = (unsigned)(Rb * K + C) * 2u; }
    const size_t kstep = (size_t)(BK * 2);
    const size_t hstep = (size_t)HALF * K * 2;
    const size_t tstep = 2 * hstep;
    const unsigned ldsw = (unsigned)wid * 1024u;
    const int aoff = lds_byte(wr * 64 + fr, fq * 8), boff = lds_byte(wc * 32 + fr, fq * 8);
#define PG8_SA(b, h) (((b) * 2 + (h)) * HTB)
#define PG8_SB(b, h) ((4 + (b) * 2 + (h)) * HTB)
#define PG8_STAGE(bufoff, gbase, voff) do { _Pragma("unroll") for (int _i = 0; _i < 2; ++_i) \
        __builtin_amdgcn_global_load_lds((const unsigned*)((const char*)(gbase) + (voff)[_i]), (PG8_LAS unsigned*)(lds + (bufoff) + ldsw + _i * 8192), 16, 0, 0); } while (0)
#define PG8_LDA(dst, b, h) do { _Pragma("unroll") for (int m = 0; m < 4; ++m) _Pragma("unroll") for (int k = 0; k < 2; ++k) dst[m][k] = *(const PG8_LAS bf16x8*)(lds + PG8_SA(b, h) + aoff + m * 2048 + k * 1024); } while (0)
#define PG8_LDB(dst, b, h) do { _Pragma("unroll") for (int n = 0; n < 2; ++n) _Pragma("unroll") for (int k = 0; k < 2; ++k) dst[n][k] = *(const PG8_LAS bf16x8*)(lds + PG8_SB(b, h) + boff + n * 2048 + k * 1024); } while (0)
#define PG8_MMA(ai, bj, At, Bt) do { __builtin_amdgcn_s_setprio(1); _Pragma("unroll") for (int m = 0; m < 4; ++m) _Pragma("unroll") for (int n = 0; n < 2; ++n) _Pragma("unroll") for (int k = 0; k < 2; ++k) \
        acc[ai][bj][m][n] = __builtin_amdgcn_mfma_f32_16x16x32_bf16(Bt[n][k], At[m][k], acc[ai][bj][m][n], 0, 0, 0); __builtin_amdgcn_s_setprio(0); } while (0)
#define PG8_WAIT_V(n) asm volatile("s_waitcnt vmcnt(" #n ")" ::: "memory")
#define PG8_WAIT_L(n) asm volatile("s_waitcnt lgkmcnt(" #n ")" ::: "memory")
#define PG8_BAR __builtin_amdgcn_s_barrier()
#define PG8_SCHED __builtin_amdgcn_sched_barrier(0)
    Unit cur, nxt; int ui = 0;
    if (!S.next(0, cur)) return;
    f32x4 acc[2][2][4][2];
#pragma unroll
    for (int a = 0; a < 2; ++a)
#pragma unroll
        for (int b = 0; b < 2; ++b)
#pragma unroll
            for (int m = 0; m < 4; ++m)
#pragma unroll
                for (int n = 0; n < 2; ++n) acc[a][b][m][n] = (f32x4){0.f, 0.f, 0.f, 0.f};
    bf16x8 At[4][2], B0[2][2], B1[2][2];
    const char* cA = (const char*)g.A + (size_t)cur.pm * tstep; const char* cB = (const char*)g.Bt + (size_t)cur.e * g.estride + (size_t)cur.pn * tstep;
    S.a_ready(cur);
    if constexpr (SP2) {
        PG8_STAGE(PG8_SB(0, 0), cB, voffB); PG8_STAGE(PG8_SB(0, 1), cB + hstep, voffB); PG8_STAGE(PG8_SA(0, 0), cA, voffA); PG8_STAGE(PG8_SA(0, 1), cA + hstep, voffA);
        if (wr == 1) PG8_BAR;
        PG8_WAIT_V(2); PG8_BAR;
        PG8_STAGE(PG8_SB(1, 0), cB + kstep, voffB); PG8_STAGE(PG8_SA(1, 0), cA + kstep, voffA); PG8_STAGE(PG8_SB(1, 1), cB + hstep + kstep, voffB);
        PG8_WAIT_V(6); PG8_BAR;
    } else {
        PG8_STAGE(PG8_SB(0, 0), cB, voffB); PG8_STAGE(PG8_SA(0, 0), cA, voffA); PG8_STAGE(PG8_SB(0, 1), cB + hstep, voffB); PG8_STAGE(PG8_SA(0, 1), cA + hstep, voffA);
        if (wr == 1) PG8_BAR;
        PG8_WAIT_V(4); PG8_BAR;
        PG8_STAGE(PG8_SB(1, 0), cB + kstep, voffB); PG8_STAGE(PG8_SA(1, 0), cA + kstep, voffA); PG8_STAGE(PG8_SB(1, 1), cB + hstep + kstep, voffB);
        PG8_WAIT_V(6); PG8_BAR;
    }
    for (;;) {
        const bool has_next = S.next(ui + 1, nxt);
        const char* nA = has_next ? (const char*)g.A + (size_t)nxt.pm * tstep : cA; const char* nB = has_next ? (const char*)g.Bt + (size_t)nxt.e * g.estride + (size_t)nxt.pn * tstep : cB;
        for (int t = 0; t < nt; t += 2) {
            const bool last = (t == nt - 2);
            const char* a1 = cA + (size_t)(t + 1) * kstep;
            const char* a2 = last ? nA : cA + (size_t)(t + 2) * kstep; const char* b2 = last ? nB : cB + (size_t)(t + 2) * kstep;
            const char* a3 = a2 + kstep; const char* b3 = b2 + kstep;
            if (last && has_next) S.a_ready(nxt);
            if constexpr (SP2) {
            PG8_LDB(B0, 0, 0); PG8_LDB(B1, 0, 1); PG8_SCHED; PG8_LDA(At, 0, 0); PG8_STAGE(PG8_SA(1, 1), a1 + hstep, voffA);
            PG8_WAIT_V(8); PG8_WAIT_L(0); PG8_BAR; PG8_MMA(0, 0, At, B0); PG8_MMA(0, 1, At, B1); PG8_BAR; PG8_SCHED;
            PG8_LDA(At, 0, 1); PG8_STAGE(PG8_SB(0, 0), b2, voffB); PG8_STAGE(PG8_SB(0, 1), b2 + hstep, voffB); PG8_STAGE(PG8_SA(0, 0), a2, voffA);
            PG8_WAIT_V(8); PG8_WAIT_L(0); PG8_BAR; PG8_MMA(1, 0, At, B0); PG8_MMA(1, 1, At, B1); PG8_BAR; PG8_SCHED;
            PG8_LDB(B0, 1, 0); PG8_LDB(B1, 1, 1); PG8_SCHED; PG8_LDA(At, 1, 0); PG8_STAGE(PG8_SA(0, 1), a2 + hstep, voffA);
            PG8_WAIT_V(8); PG8_WAIT_L(0); PG8_BAR; PG8_MMA(0, 0, At, B0); PG8_MMA(0, 1, At, B1); PG8_BAR; PG8_SCHED;
            PG8_LDA(At, 1, 1); PG8_STAGE(PG8_SB(1, 0), b3, voffB); PG8_STAGE(PG8_SB(1, 1), b3 + hstep, voffB); PG8_STAGE(PG8_SA(1, 0), a3, voffA);
            PG8_WAIT_V(8); PG8_WAIT_L(0); PG8_BAR; PG8_MMA(1, 0, At, B0); PG8_MMA(1, 1, At, B1); PG8_BAR; PG8_SCHED;
            } else {
            PG8_LDB(B0, 0, 0); PG8_SCHED; PG8_LDA(At, 0, 0); PG8_STAGE(PG8_SA(1, 1), a1 + hstep, voffA);
            PG8_WAIT_L(8); PG8_BAR; PG8_WAIT_L(0); PG8_MMA(0, 0, At, B0); PG8_BAR; PG8_SCHED;
            PG8_LDB(B1, 0, 1); PG8_STAGE(PG8_SB(0, 0), b2, voffB);
            PG8_BAR; PG8_WAIT_L(0); PG8_MMA(0, 1, At, B1); PG8_BAR;
            PG8_LDA(At, 0, 1); PG8_STAGE(PG8_SA(0, 0), a2, voffA);
            PG8_BAR; PG8_WAIT_L(0); PG8_MMA(1, 0, At, B0); PG8_BAR; PG8_SCHED;
            PG8_STAGE(PG8_SB(0, 1), b2 + hstep, voffB);
            PG8_WAIT_V(6); PG8_BAR; PG8_MMA(1, 1, At, B1); PG8_BAR;
            PG8_LDB(B0, 1, 0); PG8_SCHED; PG8_LDA(At, 1, 0); PG8_STAGE(PG8_SA(0, 1), a2 + hstep, voffA);
            PG8_WAIT_L(8); PG8_BAR; PG8_WAIT_L(0); PG8_MMA(0, 0, At, B0); PG8_BAR; PG8_SCHED;
            PG8_LDB(B1, 1, 1); PG8_STAGE(PG8_SB(1, 0), b3, voffB);
            PG8_BAR; PG8_WAIT_L(0); PG8_MMA(0, 1, At, B1); PG8_BAR;
            PG8_LDA(At, 1, 1); PG8_STAGE(PG8_SA(1, 0), a3, voffA);
            PG8_BAR; PG8_WAIT_L(0); PG8_MMA(1, 0, At, B0); PG8_BAR; PG8_SCHED;
            PG8_STAGE(PG8_SB(1, 1), b3 + hstep, voffB);
            PG8_WAIT_V(6); PG8_BAR; PG8_MMA(1, 1, At, B1); PG8_BAR;
            }
        }
        if constexpr (ALIGN_EPI) { if (wr == 0) PG8_BAR; }
        if constexpr (!Epi::AFTER_DRAIN) { E(acc, cur, wr, wc, fr, fq); S.done(cur); }
        if (!has_next) break;
#pragma unroll
        for (int a = 0; a < 2; ++a)
#pragma unroll
            for (int b = 0; b < 2; ++b)
#pragma unroll
                for (int m = 0; m < 4; ++m)
#pragma unroll
                    for (int n = 0; n < 2; ++n) acc[a][b][m][n] = (f32x4){0.f, 0.f, 0.f, 0.f};
        cur = nxt; cA = nA; cB = nB; ++ui;
        if constexpr (ALIGN_EPI) { if (wr == 1) PG8_BAR; }
    }
    PG8_WAIT_V(0);
    if constexpr (!ALIGN_EPI) { if (wr == 0) PG8_BAR; }
    PG8_BAR;
    if constexpr (Epi::AFTER_DRAIN) { E.fused(acc, cur, wr, wc, fr, fq, lds, wid, lane); S.done(cur); }
#undef PG8_SA
#undef PG8_SB
#undef PG8_STAGE
#undef PG8_LDA
#undef PG8_LDB
#undef PG8_MMA
#undef PG8_WAIT_V
#undef PG8_WAIT_L
#undef PG8_BAR
#undef PG8_SCHED
}
}

#define GAS __attribute__((address_space(1)))
#define LAS __attribute__((address_space(3)))
typedef unsigned short bf16;
typedef unsigned v4u __attribute__((ext_vector_type(4)));
typedef float f32x4 __attribute__((ext_vector_type(4)));
typedef short bf16x8 __attribute__((ext_vector_type(8)));
typedef GAS unsigned gu32;
typedef GAS unsigned long long gu64;
#define RLX_AGENT __ATOMIC_RELAXED, __HIP_MEMORY_SCOPE_AGENT
#define LDS_WAIT() asm volatile("s_waitcnt lgkmcnt(0)" ::: "memory")
#define VM_WAIT() asm volatile("s_waitcnt vmcnt(0)" ::: "memory")
__device__ __forceinline__ unsigned long long rt() { return __builtin_amdgcn_s_memrealtime(); }
__device__ __forceinline__ unsigned f2bf(float f) { unsigned u = __builtin_bit_cast(unsigned, f); return (u + 0x7fffu + ((u >> 16) & 1u)) >> 16; }
__device__ __forceinline__ unsigned pk2(float lo, float hi) { return f2bf(lo) | (f2bf(hi) << 16); }

#define XB_TMO      128
#define XB_XCNT(j)  (256  + 64 * (j))
#define XB_XSUB(j)  (1280 + 64 * (j))
#define XB_XGEN(j)  (2304 + 64 * (j))
#define XB_TOP      3328
#define XB_TOPGEN   3392
#define XCD_BAR_WORDS 3456
#define XB_SPIN_CAP (1u << 18)

__device__ __forceinline__ unsigned xb_ld(unsigned* p)              { return __hip_atomic_load(p, __ATOMIC_RELAXED, __HIP_MEMORY_SCOPE_AGENT); }
__device__ __forceinline__ unsigned xb_add(unsigned* p, unsigned v) { return __hip_atomic_fetch_add(p, v, __ATOMIC_RELAXED, __HIP_MEMORY_SCOPE_AGENT); }
__device__ __forceinline__ unsigned xb_xcc_id() { return (unsigned)__builtin_amdgcn_s_getreg((3 << 11) | 20) & 0xFu; }
#define XB_SPIN(cond, bar) do { unsigned _sp = 0; while (cond) { __builtin_amdgcn_s_sleep(1); \
    if ((++_sp & 255u) == 0u) { if (xb_ld(&(bar)[XB_TMO])) break; if (_sp > XB_SPIN_CAP) { atomicAdd(&(bar)[XB_TMO], 1u); break; } } } } while (0)

struct XcdBarrier {
    unsigned* bar; unsigned x;
    volatile LAS unsigned* st;
};

__device__ __forceinline__ XcdBarrier xcd_barrier_post(unsigned* bar, volatile LAS unsigned* st) {
    XcdBarrier b; b.bar = bar; b.x = xb_xcc_id(); b.st = st;
    if (threadIdx.x == 0) (void)xb_add(&bar[XB_XCNT(b.x)], 1u);
    return b;
}
__device__ __forceinline__ void xcd_barrier_complete(unsigned* bar, unsigned x, unsigned& nloc, unsigned& nx) {
    const unsigned G = gridDim.x * gridDim.y * gridDim.z;
    unsigned sum, cnt, mine, sp = 0u;
    for (;;) {
        sum = 0u; cnt = 0u; mine = 0u;
#pragma unroll
        for (unsigned j = 0; j < 16; ++j) { const unsigned c = xb_ld(&bar[XB_XCNT(j)]); sum += c; cnt += (c > 0u) ? 1u : 0u; mine = (j == x) ? c : mine; }
        if (sum == G) break;
        __builtin_amdgcn_s_sleep(1);
        if ((++sp & 255u) == 0u) { if (xb_ld(&bar[XB_TMO])) break; if (sp > XB_SPIN_CAP) { atomicAdd(&bar[XB_TMO], 1u); break; } }
    }
    nloc = mine > 0u ? mine : 1u; nx = cnt > 0u ? cnt : 1u;
}

__device__ __forceinline__ void xcd_barrier(const XcdBarrier& b) {
    asm volatile("s_waitcnt vmcnt(0)" ::: "memory");
    __syncthreads();
    if (threadIdx.x == 0) {
        unsigned* bar = b.bar;
        __builtin_amdgcn_s_waitcnt(0);
        unsigned nloc = b.st[0], nx = b.st[1];
        if (nloc == 0u) { xcd_barrier_complete(bar, b.x, nloc, nx); b.st[0] = nloc; b.st[1] = nx; }
        const unsigned old = xb_add(&bar[XB_XSUB(b.x)], 1u);
        const unsigned gen = old / nloc;
        if (old + 1u == (gen + 1u) * nloc) {
            __builtin_amdgcn_fence(__ATOMIC_RELEASE, "agent");
            asm volatile("s_waitcnt vmcnt(0)" ::: "memory");
            const unsigned og = xb_add(&bar[XB_TOP], 1u);
            const unsigned tg = og / nx;
            if (og + 1u == (tg + 1u) * nx) xb_add(&bar[XB_TOPGEN], 1u);
            else XB_SPIN(xb_ld(&bar[XB_TOPGEN]) == tg, bar);
            __builtin_amdgcn_fence(__ATOMIC_ACQUIRE, "agent");
            xb_add(&bar[XB_XGEN(b.x)], 1u);
            asm volatile("s_waitcnt vmcnt(0)" ::: "memory");
        } else {
            XB_SPIN(xb_ld(&bar[XB_XGEN(b.x)]) == gen, bar);
            __builtin_amdgcn_fence(__ATOMIC_ACQUIRE, "agent");
            asm volatile("s_waitcnt vmcnt(0)" ::: "memory");
        }
    }
    __syncthreads();
}

constexpr size_t MiB = 1u << 20;
constexpr size_t WS_CTL = 0, CTL_ZERO_BYTES = 1 * MiB;
constexpr size_t WS_MOD = 1 * MiB;
constexpr size_t WS_HIST = 2 * MiB;
constexpr size_t WS_META = 2 * MiB + 128 * 1024;
constexpr size_t WS_TOKE = 3 * MiB;
constexpr size_t WS_GATE = 3 * MiB + 512 * 1024;
constexpr size_t WS_RASG = 4 * MiB;
constexpr size_t WS_RGATE = 5 * MiB;
constexpr size_t WS_W1T = 8 * MiB, WS_W2T = 12 * MiB, WS_KVT = 14 * MiB, WS_QT = 18 * MiB, WS_OT = 20 * MiB;
constexpr size_t WS_MIN = 24 * MiB;
constexpr size_t WS_MOUT = 280 * MiB;
constexpr size_t WS_RA = 408 * MiB;
constexpr size_t WS_RB = 680 * MiB;
constexpr size_t WS_S = 952 * MiB;
constexpr size_t WS_X = 1080 * MiB;
constexpr size_t WS_H2 = 1208 * MiB;
constexpr size_t WS_X2B = 1272 * MiB, WS_HQ = 1336 * MiB;
constexpr size_t WS_END = 1400 * MiB;
constexpr int CW_BAR = 4096;

constexpr int RING_OFF = 0, RING_BYTES = 131072;
constexpr int LDSCTL_OFF = RING_BYTES;
constexpr int LDS_BYTES = 147456;
constexpr int NWAVES = 8, NTHREADS = 512;

typedef float f32x16 __attribute__((ext_vector_type(16)));
#define CAS __attribute__((address_space(4)))
__device__ __forceinline__ const void* karg(unsigned byteoff) {
    asm volatile("" : "+s"(byteoff));
    const CAS char* kp = (const CAS char*)__builtin_amdgcn_kernarg_segment_ptr();
    const unsigned long long v = *(const CAS unsigned long long*)(kp + byteoff);
    return (const void*)(const __attribute__((address_space(1))) void*)v;
}
typedef pg8::f32x2_t f32x2_t;
typedef short s16x4 __attribute__((ext_vector_type(4)));
typedef unsigned u32x2 __attribute__((ext_vector_type(2)));

__device__ __forceinline__ float wave_sum(float v) {
#pragma unroll
    for (int o = 1; o < 64; o <<= 1) v += __shfl_xor(v, o);
    return v;
}
__device__ __forceinline__ float bf_lo(unsigned w) { return __uint_as_float(w << 16); }
__device__ __forceinline__ float bf_hi(unsigned w) { return __uint_as_float(w & 0xffff0000u); }
__device__ __forceinline__ unsigned pkbf(float lo, float hi) { return pg8::cvt_pk_bf16(lo, hi); }

__device__ __forceinline__ void p_ada(const float* c, const float* ada_w, const float* ada_b, float* mod, LAS unsigned char* lds, int vcu, int G, int tid, int wave, int lane) {
    LAS float* sc = (LAS float*)lds;
    LAS float* red = (LAS float*)(lds + 65536);
    for (int item = vcu; item < 192; item += G) {
        const int l = item / 96, jb = item % 96;
        for (int idx = tid; idx < 16384; idx += NTHREADS) { const int b = idx >> 10, k = idx & 1023; const float v = c[idx]; sc[k * 16 + b] = v / (1.0f + __expf(-v)); }
        __syncthreads();
        float acc[16];
#pragma unroll
        for (int b = 0; b < 16; ++b) acc[b] = 0.f;
        const int k0 = wave * 128;
        const float* wp = ada_w + ((size_t)l * 1024 + k0) * 6144 + jb * 64 + lane;
#pragma unroll 8
        for (int kk = 0; kk < 128; ++kk) {
            const float wv = wp[(size_t)kk * 6144];
            const LAS f32x4* sp = (const LAS f32x4*)(sc + (k0 + kk) * 16);
#pragma unroll
            for (int q = 0; q < 4; ++q) { const f32x4 s4 = sp[q]; acc[4 * q] += s4[0] * wv; acc[4 * q + 1] += s4[1] * wv; acc[4 * q + 2] += s4[2] * wv; acc[4 * q + 3] += s4[3] * wv; }
        }
#pragma unroll
        for (int b = 0; b < 16; ++b) red[(wave * 16 + b) * 64 + lane] = acc[b];
        __syncthreads();
        for (int idx = tid; idx < 1024; idx += NTHREADS) { const int b = idx >> 6, ln = idx & 63; float s = 0.f;
#pragma unroll
            for (int w = 0; w < 8; ++w) s += red[(w * 16 + b) * 64 + ln];
            mod[((size_t)l * 16 + b) * 6144 + jb * 64 + ln] = s + ada_b[l * 6144 + jb * 64 + ln]; }
        __syncthreads();
    }
}
__device__ __forceinline__ void transpose_item(const float* W, int K, int N, bf16* WT, bool glu, LAS float* scr, int item, int lane) {
    const int nblk = N / 32, kb = item / nblk, nb = item % nblk, k0 = 64 * kb, n0 = 32 * nb;
    const int r0 = glu ? (((n0 & 1023) >> 7) * 256 + (n0 >> 10) * 128 + (n0 & 127)) : n0;
#pragma unroll 8
    for (int i = 0; i < 32; ++i) { const int kk = 2 * i + (lane >> 5); scr[kk * 33 + (lane & 31)] = W[(size_t)(k0 + kk) * N + n0 + (lane & 31)]; }
    LDS_WAIT(); asm volatile("" ::: "memory");
    const int c = lane & 7;
#pragma unroll
    for (int j = 0; j < 4; ++j) { const int n = (lane >> 3) + 8 * j; const LAS float* s = scr + (8 * c) * 33 + n;
        v4u o; o.x = pkbf(s[0 * 33], s[1 * 33]); o.y = pkbf(s[2 * 33], s[3 * 33]); o.z = pkbf(s[4 * 33], s[5 * 33]); o.w = pkbf(s[6 * 33], s[7 * 33]);
        *(GAS v4u*)(WT + (size_t)(r0 + n) * K + k0 + 8 * c) = o; }
    LDS_WAIT(); asm volatile("" ::: "memory");
}
struct WPtrs { const float *w1, *w2, *kv, *q, *o, *min, *mout; bf16 *w1t, *w2t, *kvt, *qt, *ot, *mint, *moutt; };
__device__ __forceinline__ void p_convert(const WPtrs& P, LAS unsigned char* lds, int vcu, int G, int wave, int lane) {
    LAS float* scr = (LAS float*)(lds + wave * 16384);
    const int gw = vcu * NWAVES + wave, NGW = G * NWAVES;
    constexpr int I_W1 = 16 * 64, I_W2 = 16 * 32, I_KV = 16 * 64, I_Q = 16 * 32, I_O = 16 * 32, I_SMALL = I_W1 + I_W2 + I_KV + I_Q + I_O;
    constexpr int I_MIN = 1024, I_MOUT = 512, NITEMS = I_SMALL + 64 * I_MIN + 64 * I_MOUT;
    for (int it = gw; it < NITEMS; it += NGW) {
        int r = it;
        if (r < I_W1) { transpose_item(P.w1, 1024, 2048, P.w1t, true, scr, r, lane); continue; } r -= I_W1;
        if (r < I_W2) { transpose_item(P.w2, 1024, 1024, P.w2t, false, scr, r, lane); continue; } r -= I_W2;
        if (r < I_KV) { transpose_item(P.kv, 1024, 2048, P.kvt, false, scr, r, lane); continue; } r -= I_KV;
        if (r < I_Q) { transpose_item(P.q, 1024, 1024, P.qt, false, scr, r, lane); continue; } r -= I_Q;
        if (r < I_O) { transpose_item(P.o, 1024, 1024, P.ot, false, scr, r, lane); continue; } r -= I_O;
        if (r < 64 * I_MIN) { const int mi = r / I_MIN; transpose_item(P.min + (size_t)mi * 1024 * 2048, 1024, 2048, P.mint + (size_t)mi * 2048 * 1024, true, scr, r % I_MIN, lane); continue; } r -= 64 * I_MIN;
        { const int mi = r / I_MOUT; transpose_item(P.mout + (size_t)mi * 1024 * 1024, 1024, 1024, P.moutt + (size_t)mi * 1024 * 1024, false, scr, r % I_MOUT, lane); }
    }
}
__device__ __forceinline__ void p_modulate(const float* x, const float* modl, bf16* hA, int vcu, int G, int wave, int lane) {
    const int gw = vcu * NWAVES + wave, NGW = G * NWAVES;
    for (int m = gw; m < T; m += NGW) {
        const int b = m >> 11; const float* sh = modl + (size_t)b * 6144; const float* sc = sh + 1024;
#pragma unroll
        for (int j = 0; j < 4; ++j) { const int c = 256 * j + 4 * lane;
            const f32x4 v = *(const f32x4*)(x + (size_t)m * D + c), s4 = *(const f32x4*)(sc + c), h4 = *(const f32x4*)(sh + c);
            const f32x4 h = v * (s4 + 1.0f) + h4;
            u32x2 w; w.x = pkbf(h[0], h[1]); w.y = pkbf(h[2], h[3]); *(u32x2*)(hA + (size_t)m * D + c) = w; }
    }
}
__device__ __forceinline__ void p_conv(const bf16* glu, const float* dw, const float* db, const float* lg, const float* lb, bf16* u2, LAS unsigned char* lds, int vcu, int G, int tid, int wave, int lane) {
    const int c0 = 2 * tid;
    float w0[CONVW], w1[CONVW];
#pragma unroll
    for (int w = 0; w < CONVW; ++w) { const f32x2_t v = *(const f32x2_t*)(dw + w * D + c0); w0[w] = v.x; w1[w] = v.y; }
    const f32x2_t dbv = *(const f32x2_t*)(db + c0), lgv = *(const f32x2_t*)(lg + c0), lbv = *(const f32x2_t*)(lb + c0);
    LAS float* red = (LAS float*)lds;
    constexpr int TB = 8, NWIN = TB + CONVW - 1;
    for (int u = vcu; u < T / TB; u += G) {
        const int b = u / (SEQ / TB), t0 = (u % (SEQ / TB)) * TB;
        float lo[NWIN], hi[NWIN];
#pragma unroll
        for (int j = 0; j < NWIN; ++j) { const int t = t0 - (CONVW - 1) + j; unsigned w = 0u;
            if (t >= 0) w = *(const unsigned*)(glu + ((size_t)(b * SEQ + t)) * D + c0);
            lo[j] = bf_lo(w); hi[j] = bf_hi(w); }
        float o0[TB], o1[TB], st[2 * TB];
#pragma unroll
        for (int i = 0; i < TB; ++i) { float a0 = dbv.x, a1 = dbv.y;
#pragma unroll
            for (int w = 0; w < CONVW; ++w) { a0 += lo[i + w] * w0[w]; a1 += hi[i + w] * w1[w]; }
            o0[i] = a0; o1[i] = a1; st[i] = a0 + a1; st[TB + i] = a0 * a0 + a1 * a1; }
#pragma unroll
        for (int k = 0; k < 2 * TB; ++k) st[k] = wave_sum(st[k]);
        if (lane == 0) {
#pragma unroll
            for (int k = 0; k < 2 * TB; ++k) red[wave * 16 + k] = st[k]; }
        __syncthreads();
        if (tid < 16) { float s = 0.f;
#pragma unroll
            for (int w = 0; w < 8; ++w) s += red[w * 16 + tid];
            red[128 + tid] = s; }
        __syncthreads();
#pragma unroll
        for (int i = 0; i < TB; ++i) { const float mean = red[128 + i] * (1.0f / D), var = red[128 + TB + i] * (1.0f / D) - mean * mean, rstd = 1.0f / sqrtf(var + LN_EPS);
            float y0 = (o0[i] - mean) * rstd * lgv.x + lbv.x, y1 = (o1[i] - mean) * rstd * lgv.y + lbv.y;
            y0 = y0 * pg8::sigmoidf_(y0); y1 = y1 * pg8::sigmoidf_(y1);
            *(unsigned*)(u2 + ((size_t)(b * SEQ + t0 + i)) * D + c0) = pkbf(y0, y1); }
        __syncthreads();
    }
}
__device__ __forceinline__ void p_router(const float* S, const float* lng, const float* lnb, const float* modl, const float* rw, const float* rb, float* X, bf16* H2,
                                         int* tok_e, float* gates, int* wg_hist, LAS unsigned char* lds, LAS unsigned* hist, int vcu, int G, int tid, int wave, int lane) {
    for (int idx = tid; idx < 8192; idx += NTHREADS) { const int c = idx >> 3, g = idx & 7; const f32x4 v = *(const f32x4*)(rw + c * 32 + 4 * g);
        *(LAS f32x4*)(lds + c * 128 + ((g ^ ((c >> 2) & 7)) << 4)) = v; }
    if (tid < 32) hist[tid] = 0u;
    __syncthreads();
    const int gw = vcu * NWAVES + wave, NGW = G * NWAVES;
    const int tt_me = lane >> 4, sub = (lane >> 2) & 3;
    for (int grp = gw; grp < T / 4; grp += NGW) {
        const int m0 = grp * 4, b = m0 >> 11;
        const float* sh2 = modl + (size_t)b * 6144 + 3 * 1024; const float* sc2 = sh2 + 1024;
        float hv[4][16];
#pragma unroll
        for (int tt = 0; tt < 4; ++tt) { const int m = m0 + tt;
            f32x4 v[4]; float s = 0.f;
#pragma unroll
            for (int j = 0; j < 4; ++j) { v[j] = *(const f32x4*)(S + (size_t)m * D + 256 * j + 4 * lane); s += (v[j][0] + v[j][1]) + (v[j][2] + v[j][3]); }
            const float mean = wave_sum(s) * (1.0f / D); float q = 0.f;
#pragma unroll
            for (int j = 0; j < 4; ++j) { v[j] = v[j] - mean; q += (v[j][0] * v[j][0] + v[j][1] * v[j][1]) + (v[j][2] * v[j][2] + v[j][3] * v[j][3]); }
            const float rstd = 1.0f / sqrtf(wave_sum(q) * (1.0f / D) + LN_EPS);
#pragma unroll
            for (int j = 0; j < 4; ++j) { const int c = 256 * j + 4 * lane;
                const f32x4 x1 = v[j] * rstd * *(const f32x4*)(lng + c) + *(const f32x4*)(lnb + c);
                *(f32x4*)(X + (size_t)m * D + c) = x1;
                const f32x4 h = x1 * (*(const f32x4*)(sc2 + c) + 1.0f) + *(const f32x4*)(sh2 + c);
                u32x2 w; w.x = pkbf(h[0], h[1]); w.y = pkbf(h[2], h[3]); *(u32x2*)(H2 + (size_t)m * D + c) = w;
                hv[tt][4 * j] = h[0]; hv[tt][4 * j + 1] = h[1]; hv[tt][4 * j + 2] = h[2]; hv[tt][4 * j + 3] = h[3]; }
            asm volatile("" ::: "memory");
        }
        float lg[8];
#pragma unroll
        for (int g = 0; g < 8; ++g) lg[g] = 0.f;
#pragma unroll 1
        for (int g = 0; g < 8; ++g) {
            float p[16];
#pragma unroll
            for (int k = 0; k < 16; ++k) p[k] = 0.f;
            const int sw = (g ^ (lane & 7)) << 4;
#pragma unroll
            for (int j = 0; j < 4; ++j)
#pragma unroll
                for (int i = 0; i < 4; ++i) { const int c = 256 * j + 4 * lane + i;
                    const f32x4 w4 = *(const LAS f32x4*)(lds + c * 128 + sw);
#pragma unroll
                    for (int tt = 0; tt < 4; ++tt) { const float hx = hv[tt][4 * j + i]; p[tt * 4] += hx * w4[0]; p[tt * 4 + 1] += hx * w4[1]; p[tt * 4 + 2] += hx * w4[2]; p[tt * 4 + 3] += hx * w4[3]; } }
            float a8[8], a4[4], a2[2], a1;
            { const bool up = (lane & 32) != 0;
#pragma unroll
              for (int k = 0; k < 8; ++k) { const float keep = up ? p[k + 8] : p[k], send = up ? p[k] : p[k + 8]; a8[k] = keep + __shfl_xor(send, 32); } }
            { const bool up = (lane & 16) != 0;
#pragma unroll
              for (int k = 0; k < 4; ++k) { const float keep = up ? a8[k + 4] : a8[k], send = up ? a8[k] : a8[k + 4]; a4[k] = keep + __shfl_xor(send, 16); } }
            { const bool up = (lane & 8) != 0;
#pragma unroll
              for (int k = 0; k < 2; ++k) { const float keep = up ? a4[k + 2] : a4[k], send = up ? a4[k] : a4[k + 2]; a2[k] = keep + __shfl_xor(send, 8); } }
            { const bool up = (lane & 4) != 0; const float keep = up ? a2[1] : a2[0], send = up ? a2[0] : a2[1]; a1 = keep + __shfl_xor(send, 4); }
            a1 += __shfl_xor(a1, 2); a1 += __shfl_xor(a1, 1);
            a1 += rb[4 * g + sub];
#pragma unroll
            for (int gg = 0; gg < 8; ++gg) lg[gg] = (gg == g) ? a1 : lg[gg];
        }
        float tv[4]; int te[4];
#pragma unroll
        for (int k = 0; k < 4; ++k) {
            float bv = lg[0]; int be = sub;
#pragma unroll
            for (int g = 1; g < 8; ++g) { const bool better = lg[g] > bv; bv = better ? lg[g] : bv; be = better ? 4 * g + sub : be; }
#pragma unroll
            for (int o = 4; o <= 8; o <<= 1) { const float ov = __shfl_xor(bv, o); const int oe = __shfl_xor(be, o); const bool better = (ov > bv) || (ov == bv && oe < be); bv = better ? ov : bv; be = better ? oe : be; }
            tv[k] = bv; te[k] = be;
#pragma unroll
            for (int g = 0; g < 8; ++g) lg[g] = (4 * g + sub == be) ? -INFINITY : lg[g];
        }
        const float e1 = __expf(tv[1] - tv[0]), e2 = __expf(tv[2] - tv[0]), e3 = __expf(tv[3] - tv[0]), inv = 1.0f / (1.0f + e1 + e2 + e3);
        const int kk = lane & 15;
        if (kk < 4) { const int e = kk == 0 ? te[0] : kk == 1 ? te[1] : kk == 2 ? te[2] : te[3]; const float gt = (kk == 0 ? 1.0f : kk == 1 ? e1 : kk == 2 ? e2 : e3) * inv;
            const unsigned lpos = atomicAdd((unsigned*)(hist + e), 1u);
            const int a = (m0 + tt_me) * 4 + kk; tok_e[a] = e | (int)(lpos << 8); gates[a] = gt; }
    }
    __syncthreads();
    if (tid < 32) wg_hist[vcu * 32 + tid] = (int)hist[tid];
}
__device__ __forceinline__ void p_scatter(const bf16* H2, const int* tok_e, const float* gates, const int* wg_hist, bf16* xs, int* row_asg, float* row_gate, int* meta,
                                          LAS unsigned char* lds, int vcu, int G, int tid, int wave, int lane) {
    LAS int* sm = (LAS int*)lds;
    { const int e = tid & 31, part = tid >> 5; int p = 0, s = 0;
      for (int w = part * 16; w < part * 16 + 16; ++w) { if (w < G) { const int h = wg_hist[w * 32 + e]; s += h; if (w < vcu) p += h; } }
      sm[part * 32 + e] = p; sm[512 + part * 32 + e] = s; }
    __syncthreads();
    if (tid < 32) { int p = 0, s = 0;
#pragma unroll
        for (int q = 0; q < 16; ++q) { p += sm[q * 32 + tid]; s += sm[512 + q * 32 + tid]; }
        sm[1024 + tid] = p; sm[1056 + tid] = s; }
    __syncthreads();
    if (tid == 0) { int us = 0; for (int e = 0; e < NE; ++e) { sm[1120 + e] = us; sm[1088 + e] = us * 256; us += (sm[1056 + e] + 255) >> 8; } sm[1120 + NE] = us; }
    __syncthreads();
    if (vcu == 0 && tid <= NE) meta[tid] = sm[1120 + tid];
    const int gw = vcu * NWAVES + wave, NGW = G * NWAVES;
    for (int e = vcu; e < NE; e += G) { const int r0 = sm[1088 + e] + sm[1056 + e], r1 = sm[1088 + e] + (((sm[1056 + e] + 255) >> 8) << 8);
        for (int r = r0 + wave; r < r1; r += NWAVES) { v4u z = {0u, 0u, 0u, 0u}; *(v4u*)(xs + (size_t)r * D + 8 * lane) = z; *(v4u*)(xs + (size_t)r * D + 512 + 8 * lane) = z;
            if (lane == 0) { row_asg[r] = -1; row_gate[r] = 0.f; } } }
    for (int grp = gw; grp < T / 4; grp += NGW) {
#pragma unroll
        for (int tt = 0; tt < 4; ++tt) { const int m = grp * 4 + tt;
            const v4u r0 = *(const v4u*)(H2 + (size_t)m * D + 8 * lane), r1 = *(const v4u*)(H2 + (size_t)m * D + 512 + 8 * lane);
#pragma unroll
            for (int k = 0; k < 4; ++k) { const int te = tok_e[m * 4 + k], e = te & 31, lpos = te >> 8; const int dest = sm[1088 + e] + sm[1024 + e] + lpos;
                *(v4u*)(xs + (size_t)dest * D + 8 * lane) = r0; *(v4u*)(xs + (size_t)dest * D + 512 + 8 * lane) = r1;
                if (lane == 0) { row_asg[dest] = m * 4 + k; row_gate[dest] = gates[m * 4 + k]; } } }
    }
}
__device__ __forceinline__ int moe_table(const int* meta, LAS int* ru2e, int tid) {
    __syncthreads();
    if (tid < NE) { const int u0 = meta[tid], u1 = meta[tid + 1]; for (int u = u0; u < u1; ++u) ru2e[u] = tid; }
    const int nru = meta[NE];
    __syncthreads();
    return __builtin_amdgcn_readfirstlane(nru);
}
template <int LAYER> __device__ __forceinline__ void p_final(float* X, const bf16* yk, const float* lng, const float* lnb, const float* modl, const float* modn, bf16* x2b, bf16* hq, float* out,
                                                               int vcu, int G, int wave, int lane) {
    const int gw = vcu * NWAVES + wave, NGW = G * NWAVES;
    for (int m = gw; m < T; m += NGW) {
        const int b = m >> 11; const float* g2 = modl + (size_t)b * 6144 + 5 * 1024;
        f32x4 v[4]; float s = 0.f;
#pragma unroll
        for (int j = 0; j < 4; ++j) { const int c = 256 * j + 4 * lane;
            f32x4 y = {0.f, 0.f, 0.f, 0.f};
#pragma unroll
            for (int k = 0; k < 4; ++k) { const u32x2 w = *(const u32x2*)(yk + ((size_t)m * 4 + k) * D + c); y[0] += bf_lo(w.x); y[1] += bf_hi(w.x); y[2] += bf_lo(w.y); y[3] += bf_hi(w.y); }
            v[j] = *(const f32x4*)(X + (size_t)m * D + c) * ALPHA_DN + (*(const f32x4*)(g2 + c) + 1.0f) * y;
            s += (v[j][0] + v[j][1]) + (v[j][2] + v[j][3]); }
        const float mean = wave_sum(s) * (1.0f / D); float q = 0.f;
#pragma unroll
        for (int j = 0; j < 4; ++j) { v[j] = v[j] - mean; q += (v[j][0] * v[j][0] + v[j][1] * v[j][1]) + (v[j][2] * v[j][2] + v[j][3] * v[j][3]); }
        const float rstd = 1.0f / sqrtf(wave_sum(q) * (1.0f / D) + LN_EPS);
#pragma unroll
        for (int j = 0; j < 4; ++j) { const int c = 256 * j + 4 * lane;
            const f32x4 x2 = v[j] * rstd * *(const f32x4*)(lng + c) + *(const f32x4*)(lnb + c);
            if (LAYER == 0) {
                *(f32x4*)(X + (size_t)m * D + c) = x2;
                u32x2 w; w.x = pkbf(x2[0], x2[1]); w.y = pkbf(x2[2], x2[3]); *(u32x2*)(x2b + (size_t)m * D + c) = w;
                const float* sh = modn + (size_t)b * 6144; const f32x4 h = x2 * (*(const f32x4*)(sh + 1024 + c) + 1.0f) + *(const f32x4*)(sh + c);
                u32x2 w2; w2.x = pkbf(h[0], h[1]); w2.y = pkbf(h[2], h[3]); *(u32x2*)(hq + (size_t)m * D + c) = w2;
            } else *(f32x4*)(out + (size_t)m * D + c) = x2;
        }
    }
}
__device__ __forceinline__ int crow(int r, int hi) { return (r & 3) + 8 * (r >> 2) + 4 * hi; }
#define MFMA32(a, b, c) __builtin_amdgcn_mfma_f32_32x32x16_bf16((a), (b), (c), 0, 0, 0)
__device__ __forceinline__ bf16x8 pack8(const f32x16& x, int s) {
    v4u p; p.x = pkbf(x[8 * s], x[8 * s + 1]); p.y = pkbf(x[8 * s + 2], x[8 * s + 3]); p.z = pkbf(x[8 * s + 4], x[8 * s + 5]); p.w = pkbf(x[8 * s + 6], x[8 * s + 7]);
    return __builtin_bit_cast(bf16x8, p);
}
template <bool DIAG> __device__ __forceinline__ void attn_tile(const LAS unsigned char* Ks, const LAS unsigned char* Vs, const bf16* qp, const bf16x8& ones, const bf16x8& Ua, const bf16x8& Ub,
                                                                f32x16 (&o)[2], f32x16& Rv, int kv0, int qpos, int r, int h) {
    constexpr int KP = 144, VP = 136;
    f32x16 p0 = {}, p1 = {};
    bf16x8 qr[4];
#pragma unroll
    for (int s = 0; s < 4; ++s) qr[s] = *(const bf16x8*)(qp + 16 * s);
#pragma unroll
    for (int s = 0; s < 4; ++s) { const bf16x8 k0 = *(const LAS bf16x8*)(Ks + r * KP + (16 * s + 8 * h) * 2), k1 = *(const LAS bf16x8*)(Ks + (32 + r) * KP + (16 * s + 8 * h) * 2);
        p0 = MFMA32(k0, qr[s], p0); p1 = MFMA32(k1, qr[s], p1); }
    f32x16 L0, L1;
#pragma unroll
    for (int i = 0; i < 16; ++i) {
        { const float z = p0[i]; float L = -(fmaxf(z, 0.f) + __builtin_amdgcn_logf(1.0f + __builtin_amdgcn_exp2f(-fabsf(z))));
          if (DIAG) L = (kv0 + crow(i, h) < qpos) ? L : 0.f; L0[i] = L; p0[i] = z + L; }
        { const float z = p1[i]; float L = -(fmaxf(z, 0.f) + __builtin_amdgcn_logf(1.0f + __builtin_amdgcn_exp2f(-fabsf(z))));
          if (DIAG) L = (kv0 + 32 + crow(i, h) < qpos) ? L : 0.f; L1[i] = L; p1[i] = z + L; }
    }
    __builtin_amdgcn_sched_barrier(0);
    const bf16x8 l0a = pack8(L0, 0), l0b = pack8(L0, 1), l1a = pack8(L1, 0), l1b = pack8(L1, 1);
    bf16x8 pa[4];
    f32x16 T1 = MFMA32(ones, l1a, Rv); T1 = MFMA32(ones, l1b, T1);
    { f32x16 S1 = MFMA32(Ua, l1a, Rv);   S1 = MFMA32(Ub, l1b, S1);
#pragma unroll
      for (int i = 0; i < 16; ++i) { float a1 = __builtin_amdgcn_exp2f(p1[i] + S1[i]); if (DIAG) a1 = (kv0 + 32 + crow(i, h) < qpos) ? a1 : 0.f; p1[i] = a1; }
      pa[2] = pack8(p1, 0); pa[3] = pack8(p1, 1); }
    __builtin_amdgcn_sched_barrier(0);
    { f32x16 S0 = MFMA32(Ua, l0a, T1);   S0 = MFMA32(Ub, l0b, S0);
#pragma unroll
      for (int i = 0; i < 16; ++i) { float a0 = __builtin_amdgcn_exp2f(p0[i] + S0[i]); if (DIAG) a0 = (kv0 + crow(i, h) < qpos) ? a0 : 0.f; p0[i] = a0; }
      pa[0] = pack8(p0, 0); pa[1] = pack8(p0, 1); }
    Rv = MFMA32(ones, l0a, T1); Rv = MFMA32(ones, l0b, Rv);
    __builtin_amdgcn_sched_barrier(0);
#pragma unroll
    for (int dh = 0; dh < 2; ++dh)
#pragma unroll
        for (int hf = 0; hf < 2; ++hf)
#pragma unroll
            for (int c = 0; c < 2; ++c) { const LAS unsigned char* ap = Vs + (32 * dh + r) * VP + (32 * hf + 16 * c + 4 * h) * 2;
                const s16x4 lo = *(const LAS s16x4*)ap, hi = *(const LAS s16x4*)(ap + 16);
                const bf16x8 vf = __builtin_shufflevector(lo, hi, 0, 1, 2, 3, 4, 5, 6, 7);
                o[dh] = MFMA32(pa[2 * hf + c], vf, o[dh]); }
}
__device__ __forceinline__ void p_attn(const bf16* Q, const bf16* K, const bf16* VT, bf16* O, LAS unsigned char* lds, int vcu, int G, int tid, int wave, int lane) {
    constexpr int KP = 144, VP = 136;
    LAS unsigned char* Ks = lds; LAS unsigned char* Vs = lds + 64 * KP;
    const int r = lane & 31, h = lane >> 5;
    bf16x8 ones, Ua, Ub;
#pragma unroll
    for (int j = 0; j < 8; ++j) { ones[j] = (short)0x3F80; const int ka = 8 * (j >> 2) + 4 * h + (j & 3), kb = 16 + ka; Ua[j] = (ka > r) ? (short)0x3F80 : (short)0; Ub[j] = (kb > r) ? (short)0x3F80 : (short)0; }
    const int srow = tid >> 3, sch = tid & 7;
    for (int bh = vcu; bh < NBATCH * NHEAD; bh += G) {
        const int b = bh >> 4, hh = bh & 15; const size_t rowbase = (size_t)b * SEQ;
        for (int qb = 0; qb < SEQ / 256; ++qb) {
            const int q0 = qb * 256, qw = q0 + 32 * wave;
            const bf16* qp = Q + (rowbase + qw + r) * D + hh * HDIM + 8 * h;
            f32x16 o[2]; o[0] = f32x16{}; o[1] = f32x16{}; f32x16 Rv = f32x16{};
            const int jt_hi = (q0 + 256) / 64 - 1;
            v4u kreg = *(const v4u*)(K + (rowbase + 64 * jt_hi + srow) * D + hh * HDIM + 8 * sch);
            v4u vreg = *(const v4u*)(VT + (size_t)(hh * HDIM + srow) * T + rowbase + 64 * jt_hi + 8 * sch);
            for (int jt = jt_hi; jt >= 0; --jt) {
                __syncthreads();
                *(LAS v4u*)(Ks + srow * KP + sch * 16) = kreg;
                { u32x2 a = {vreg.x, vreg.y}, c2 = {vreg.z, vreg.w}; *(LAS u32x2*)(Vs + srow * VP + sch * 16) = a; *(LAS u32x2*)(Vs + srow * VP + sch * 16 + 8) = c2; }
                __syncthreads();
                if (jt > 0) { kreg = *(const v4u*)(K + (rowbase + 64 * (jt - 1) + srow) * D + hh * HDIM + 8 * sch);
                              vreg = *(const v4u*)(VT + (size_t)(hh * HDIM + srow) * T + rowbase + 64 * (jt - 1) + 8 * sch); }
                const int kv0 = 64 * jt;
                if (kv0 <= qw + 30) {
                    if (kv0 + 63 >= qw) attn_tile<true>(Ks, Vs, qp, ones, Ua, Ub, o, Rv, kv0, qw + r, r, h);
                    else attn_tile<false>(Ks, Vs, qp, ones, Ua, Ub, o, Rv, kv0, qw + r, r, h);
                }
            }
#pragma unroll
            for (int dh = 0; dh < 2; ++dh)
#pragma unroll
                for (int i = 0; i < 16; ++i) { const unsigned w = pkbf(o[dh][i], 0.f); O[(rowbase + qw + crow(i, h)) * D + hh * HDIM + 32 * dh + r] = (bf16)(w & 0xffffu); }
        }
    }
}

#ifndef MK_PER_PHASE
#define MK_PER_PHASE 0
#endif
constexpr int N_PHASES = 18;
struct Args { const float* in[23]; float* out; unsigned char* ws; int ph_lo, ph_hi; };
static_assert(sizeof(Args) == 23 * 8 + 8 + 8 + 8, "Args has no padding bytes");

__global__ void __launch_bounds__(NTHREADS, 2) yoco_fwd(Args args) {
    extern __shared__ __attribute__((aligned(16))) unsigned char lds_raw[];
    LAS unsigned char* lds = (LAS unsigned char*)lds_raw;
    const int G = gridDim.x; const int bx = blockIdx.x; const int vcu = (G % 8 == 0) ? (bx % 8) * (G / 8) + bx / 8 : bx;
    gu32* ctl = (gu32*)(args.ws + WS_CTL);
    for (int u = threadIdx.x; u < (LDS_BYTES - LDSCTL_OFF) / 4; u += NTHREADS) ((LAS unsigned*)(lds + LDSCTL_OFF))[u] = 0u;
    __syncthreads();
    XcdBarrier bar; bar.bar = (unsigned*)(ctl + CW_BAR); bar.x = 0; bar.st = nullptr;
    if (!MK_PER_PHASE) bar = xcd_barrier_post((unsigned*)(ctl + CW_BAR), (volatile LAS unsigned*)(lds + LDSCTL_OFF));
    LAS unsigned* hist = (LAS unsigned*)(lds + LDSCTL_OFF + 64);
    LAS int* ru2e = (LAS int*)(lds + LDSCTL_OFF + 256);
    const int lo = args.ph_lo, hi = args.ph_hi;
#define LAUNDER() int tid = threadIdx.x; asm volatile("" : "+v"(tid)); const int lane = tid & 63, wave = __builtin_amdgcn_readfirstlane(tid >> 6); (void)lane; (void)wave
#ifndef PHASE_MASK
#define PHASE_MASK 0x3ffff
#endif
#define IN(k) ((((PHASE_MASK) >> (k)) & 1) && lo <= (k) && (k) < hi)
#define SEAM(k) do { if (IN(k) && IN((k) + 1)) xcd_barrier(bar); } while (0)

#define KIN(i) ((const float*)karg(8u * (unsigned)(i)))
#define WSP(type, off) ((type*)((unsigned char*)karg(192u) + (off)))
#define xin KIN(0)
#define cin KIN(1)
#define ada_w KIN(2)
#define ada_b KIN(3)
#define ln_g KIN(4)
#define ln_b KIN(5)
#define cv_b1 KIN(7)
#define cv_dw KIN(8)
#define cv_db KIN(9)
#define cv_lg KIN(10)
#define cv_lb KIN(11)
#define cv_b2 KIN(13)
#define router_w KIN(17)
#define router_b KIN(18)
#define moe_b_in KIN(20)
#define moe_b_out KIN(22)
#define mod WSP(float, WS_MOD)
#define wg_hist WSP(int, WS_HIST)
#define meta WSP(int, WS_META)
#define tok_e WSP(int, WS_TOKE)
#define gates WSP(float, WS_GATE)
#define row_asg WSP(int, WS_RASG)
#define row_gate WSP(float, WS_RGATE)
#define w1t WSP(bf16, WS_W1T)
#define w2t WSP(bf16, WS_W2T)
#define kvt WSP(bf16, WS_KVT)
#define qt WSP(bf16, WS_QT)
#define ot WSP(bf16, WS_OT)
#define mint WSP(bf16, WS_MIN)
#define moutt WSP(bf16, WS_MOUT)
#define xs WSP(bf16, WS_RA)
#define yk WSP(bf16, WS_RA)
#define act WSP(bf16, WS_RB)
#define hA WSP(bf16, WS_RB)
#define glu WSP(bf16, WS_RB + 64 * MiB)
#define u2 WSP(bf16, WS_RB + 128 * MiB)
#define Qb WSP(bf16, WS_RB)
#define Kb WSP(bf16, WS_RB + 64 * MiB)
#define VTb WSP(bf16, WS_RB + 128 * MiB)
#define Ob WSP(bf16, WS_RB + 192 * MiB)
#define Sb WSP(float, WS_S)
#define Xb WSP(float, WS_X)
#define H2 WSP(bf16, WS_H2)
#define x2b WSP(bf16, WS_X2B)
#define hq WSP(bf16, WS_HQ)
#define d_outp ((float*)karg(184u))

    if (IN(0)) { LAUNDER();
        p_ada(cin, ada_w, ada_b, mod, lds, vcu, G, tid, wave, lane);
        WPtrs P{KIN(6), KIN(12), KIN(14), KIN(15), KIN(16), KIN(19), KIN(21), w1t, w2t, kvt, qt, ot, mint, moutt};
        p_convert(P, lds, vcu, G, wave, lane);
    }
    SEAM(0);
    if (IN(1)) { LAUNDER(); p_modulate(xin, mod, hA, vcu, G, wave, lane); }
    SEAM(1);
    if (IN(2)) { pg8::Gemm g{hA, w1t, 1024, 0}; pg8::StaticOrder S; S.init(T, 2048, G, bx); pg8::EpiGlu<0> E{glu, cv_b1};
        pg8::gemm_phase<pg8::EpiGlu<0>, pg8::StaticOrder, true, true>(lds + RING_OFF, g, S, E); }
    SEAM(2);
    if (IN(3)) { LAUNDER(); p_conv(glu, cv_dw, cv_db, cv_lg, cv_lb, u2, lds, vcu, G, tid, wave, lane); }
    SEAM(3);
    if (IN(4)) { pg8::Gemm g{u2, w2t, 1024, 0}; pg8::StaticOrder S; S.init(T, 1024, G, bx); pg8::EpiResid E{xin, Sb, cv_b2, mod + 2 * 1024};
        pg8::gemm_phase<pg8::EpiResid, pg8::StaticOrder, true, true>(lds + RING_OFF, g, S, E); }
    SEAM(4);
#pragma unroll 1
    for (int l = 0; l < 2; ++l) {
        const int pb = l == 0 ? 5 : 13;
        const size_t modoff = (size_t)l * 16 * 6144;
        if (l == 1) {
            if (IN(10)) {
                { pg8::Gemm g{x2b, kvt, 1024, 0}; pg8::StaticOrder S; S.init(T, 1024, G, bx); pg8::EpiBf16 E{Kb, 1024, 1.0f};
                  pg8::gemm_phase<pg8::EpiBf16, pg8::StaticOrder, true, true>(lds + RING_OFF, g, S, E); }
                { pg8::Gemm g{kvt + (size_t)1024 * 1024, x2b, 1024, 0}; pg8::StaticOrder S; S.init(1024, T, G, bx); pg8::EpiBf16 E{VTb, T, 1.0f};
                  pg8::gemm_phase<pg8::EpiBf16, pg8::StaticOrder, true, true>(lds + RING_OFF, g, S, E); }
                { pg8::Gemm g{hq, qt, 1024, 0}; pg8::StaticOrder S; S.init(T, 1024, G, bx); pg8::EpiBf16 E{Qb, 1024, 0.125f * LOG2E};
                  pg8::gemm_phase<pg8::EpiBf16, pg8::StaticOrder, true, true>(lds + RING_OFF, g, S, E); }
            }
            SEAM(10);
            if (IN(11)) { LAUNDER(); p_attn(Qb, Kb, VTb, Ob, lds, vcu, G, tid, wave, lane); }
            SEAM(11);
            if (IN(12)) { pg8::Gemm g{Ob, ot, 1024, 0}; pg8::StaticOrder S; S.init(T, 1024, G, bx); pg8::EpiResid E{Xb, Sb, nullptr, mod + modoff + 2 * 1024};
                pg8::gemm_phase<pg8::EpiResid, pg8::StaticOrder, true, true>(lds + RING_OFF, g, S, E); }
            SEAM(12);
        }
        if (IN(pb)) { LAUNDER(); p_router(Sb, ln_g + (size_t)(l * 2) * D, ln_b + (size_t)(l * 2) * D, mod + modoff, router_w + (size_t)l * D * NE, router_b + l * NE, Xb, H2, tok_e, gates, wg_hist, lds, hist, vcu, G, tid, wave, lane); }
        SEAM(pb);
        if (IN(pb + 1)) { LAUNDER(); p_scatter(H2, tok_e, gates, wg_hist, xs, row_asg, row_gate, meta, lds, vcu, G, tid, wave, lane); }
        SEAM(pb + 1);
        if (IN(pb + 2)) { LAUNDER(); const int nru = moe_table(meta, ru2e, tid);
            pg8::Gemm g{xs, mint + (size_t)l * NE * 2048 * 1024, 1024, (size_t)2048 * 1024 * 2}; pg8::MoeOrder S; S.init(nru, 8, G, bx, ru2e);
            pg8::EpiGlu<1> E{act, moe_b_in + (size_t)l * NE * 2048};
            pg8::gemm_phase<pg8::EpiGlu<1>, pg8::MoeOrder, true, true>(lds + RING_OFF, g, S, E); }
        SEAM(pb + 2);
        if (IN(pb + 3)) { LAUNDER(); const int nru = moe_table(meta, ru2e, tid);
            pg8::Gemm g{act, moutt + (size_t)l * NE * 1024 * 1024, 1024, (size_t)1024 * 1024 * 2}; pg8::MoeOrder S; S.init(nru, 4, G, bx, ru2e);
            pg8::EpiMoeOut E{yk, moe_b_out + (size_t)l * NE * 1024, row_asg, row_gate};
            pg8::gemm_phase<pg8::EpiMoeOut, pg8::MoeOrder, true, true>(lds + RING_OFF, g, S, E); }
        SEAM(pb + 3);
        if (IN(pb + 4)) { LAUNDER();
            if (l == 0) p_final<0>(Xb, yk, ln_g + (size_t)(l * 2 + 1) * D, ln_b + (size_t)(l * 2 + 1) * D, mod + modoff, mod + (size_t)16 * 6144, x2b, hq, d_outp, vcu, G, wave, lane);
            else p_final<1>(Xb, yk, ln_g + (size_t)(l * 2 + 1) * D, ln_b + (size_t)(l * 2 + 1) * D, mod + modoff, mod, x2b, hq, d_outp, vcu, G, wave, lane);
        }
        if (l == 0) SEAM(9);
    }
#undef IN
#undef SEAM
}
#undef xin
#undef cin
#undef mod
#undef meta
#undef act
#undef glu
#undef gates
#undef xs
#undef yk
#undef hq
#undef ot
#undef qt
#undef u2
#undef hA

extern "C" void kernel_launch(void* const* d_in, const int* in_sizes, int n_in, void* d_out, int out_size, void* d_ws, size_t ws_size, hipStream_t stream) {
    static int grid = 0;
    if (grid == 0) {
        if (n_in != 23 || in_sizes[0] != T * D || out_size != T * D || ws_size < WS_END) { fprintf(stderr, "kernel_launch: unexpected problem: n_in %d in0 %d out %d ws %zu (need %zu); nothing launched\n", n_in, n_in > 0 ? in_sizes[0] : -1, out_size, ws_size, (size_t)WS_END); grid = -1; return; }
        int dev = 0, cus = 0, per_cu = 0;
        if (hipGetDevice(&dev) != hipSuccess || hipDeviceGetAttribute(&cus, hipDeviceAttributeMultiprocessorCount, dev) != hipSuccess) { fprintf(stderr, "kernel_launch: device query failed\n"); grid = -1; return; }
        if (hipFuncSetAttribute((const void*)yoco_fwd, hipFuncAttributeMaxDynamicSharedMemorySize, LDS_BYTES) != hipSuccess) { fprintf(stderr, "kernel_launch: hipFuncSetAttribute failed\n"); grid = -1; return; }
        if (hipOccupancyMaxActiveBlocksPerMultiprocessor(&per_cu, (const void*)yoco_fwd, NTHREADS, LDS_BYTES) != hipSuccess || per_cu < 1)
            fprintf(stderr, "kernel_launch: note: occupancy query reports %d workgroups per CU\n", per_cu);
        (void)hipGetLastError();
        grid = cus;
        if (grid % 8 != 0 || grid > 256) { fprintf(stderr, "kernel_launch: built for <= 256 CUs in 8 XCDs, got %d\n", grid); }
    }
    if (grid < 0) return;
    if (hipMemsetAsync((char*)d_ws + WS_CTL, 0, CTL_ZERO_BYTES, stream) != hipSuccess) { fprintf(stderr, "kernel_launch: memset failed\n"); return; }
    Args a; memset(&a, 0, sizeof(a));
    for (int i = 0; i < 23; ++i) a.in[i] = (const float*)d_in[i];
    a.out = (float*)d_out; a.ws = (unsigned char*)d_ws;
#if MK_PER_PHASE
    for (int p = 0; p < N_PHASES; ++p) { a.ph_lo = p; a.ph_hi = p + 1; hipLaunchKernelGGL(yoco_fwd, dim3(grid), dim3(NTHREADS), LDS_BYTES, stream, a); }
#else
    a.ph_lo = 0; a.ph_hi = N_PHASES;
    hipLaunchKernelGGL(yoco_fwd, dim3(grid), dim3(NTHREADS), LDS_BYTES, stream, a);
#endif
    const hipError_t le = hipPeekAtLastError();
    if (le != hipSuccess) fprintf(stderr, "kernel_launch: launch failed: %s\n", hipGetErrorName(le));
}
```

```cpp
#include <hip/hip_runtime.h>
#include <cstdio>
#include <cstdint>
#include <cstring>

constexpr int T = 32768, D = 1024, NBATCH = 16, SEQ = 2048, NHEAD = 16, HDIM = 64, NE = 32, TOPK = 4, CONVW = 31;
constexpr int NASG = T * TOPK;
constexpr int APAD = NASG + NE * 256;
constexpr int MAXRU = APAD / 256;
constexpr float LN_EPS = 1e-5f;
constexpr float ALPHA_DN = 1.41421356237309515f;
constexpr float LOG2E = 1.4426950408889634f;

namespace pg8 {
#define PG8_LAS __attribute__((address_space(3)))
typedef unsigned short bf16_t;
typedef short bf16x8 __attribute__((ext_vector_type(8)));
typedef float f32x4 __attribute__((ext_vector_type(4)));
typedef unsigned u32x4 __attribute__((ext_vector_type(4)));
constexpr int BM = 256, BK = 64, HALF = 128, HTB = HALF * BK * 2  , STAGE_BYTES = 8 * HTB, NXCD = 8, WGM = 8;

__host__ __device__ __forceinline__ int lds_byte(int r, int c) { const int st = (r >> 4) * 2 + (c >> 5), rr = r & 15, cc = c & 31, ob = rr * 64 + cc * 2; return st * 1024 + (ob ^ (((ob >> 9) & 1) << 5)); }
__host__ __device__ __forceinline__ void stage_rc(int b, int& R, int& C) { const int st = b / 1024, sb = b % 1024, swz = sb ^ (((sb >> 9) & 1) << 5); R = (st >> 1) * 16 + swz / 64; C = (st & 1) * 32 + (swz % 64) / 2; }
__host__ __device__ __forceinline__ int perm32(int rho) { const int n = rho >> 4, i = rho & 15; return 8 * (i >> 2) + 4 * n + (i & 3); }

#ifndef GLDS_KEEP_M0
#define GLDS_KEEP_M0 0
#endif
template <int OFF> __device__ __forceinline__ void glds16_i(unsigned voff, const void* sbase, unsigned ldsbase) {
#if GLDS_KEEP_M0
    unsigned keep;
    asm volatile("s_mov_b32 %0, m0\n\ts_add_u32 m0, %3, %4\n\ts_nop 0\n\tglobal_load_lds_dwordx4 %1, %2\n\ts_mov_b32 m0, %0" : "=&s"(keep) : "v"(voff), "s"(sbase), "s"(ldsbase), "n"(OFF) : "memory", "scc");
#else
    asm volatile("s_add_u32 m0, %2, %3\n\ts_nop 0\n\tglobal_load_lds_dwordx4 %0, %1" :: "v"(voff), "s"(sbase), "s"(ldsbase), "n"(OFF) : "memory", "scc");
#endif
}
__device__ __forceinline__ void glds4(unsigned voff, const void* sbase, unsigned lds_dst) { unsigned keep;
    asm volatile("s_mov_b32 %0, m0\n\ts_mov_b32 m0, %3\n\ts_nop 0\n\tglobal_load_lds_dword %1, %2\n\ts_mov_b32 m0, %0" : "=&s"(keep) : "v"(voff), "s"(sbase), "s"(lds_dst) : "memory"); }
struct Unit { int pm, pn, e; };
struct Gemm { const bf16_t* A; const bf16_t* Bt; int K; size_t estride; const int* rowtok; PG8_LAS int* tab; };

struct StaticOrder {
    int nM, nN, nwg, G, c;
    __device__ void init(int M, int N, int G_, int c_) { nM = M / BM; nN = N / BM; nwg = nM * nN; G = G_; c = c_; }
    __device__ bool next(int i, Unit& u) const {
        const long L = (long)i * G + c; if (L >= nwg) return false;
        int wgid = (int)L; { const int q = nwg / NXCD, r = nwg % NXCD, xcd = wgid % NXCD, off = wgid / NXCD; wgid = (xcd < r ? xcd * (q + 1) : r * (q + 1) + (xcd - r) * q) + off; }
        const int nig = WGM * nN, gid = wgid / nig, fm = gid * WGM, gsz = (nM - fm) < WGM ? (nM - fm) : WGM;
        u.pm = fm + ((wgid % nig) % gsz); u.pn = (wgid % nig) / gsz; u.e = 0; return true;
    }
    __device__ __forceinline__ void a_ready(const Unit&) const {}
    __device__ __forceinline__ void done(const Unit&) const {}
    __device__ __forceinline__ void flush() const {}
};
#ifndef MOE_WGM
#define MOE_WGM 16
#endif
template <int HMODE> struct MoeOrderT {
    int nM, nN, nwg, G, c; const PG8_LAS int* ru2e; PG8_LAS int* utab;
    unsigned* cnt; unsigned need; int rot;
    __device__ void init(int nM_, int nN_, int G_, int c_, const PG8_LAS int* t, PG8_LAS int* ut) { nM = nM_; nN = nN_; nwg = nM * nN; G = G_; c = c_; ru2e = t; utab = ut; cnt = nullptr; need = 0u; rot = 0; allflag = nullptr; allneed = 0u; ncall = 0u; pend = -1; }
    __device__ void build(int tid) const {
        if (tid < 32) { const long L = (long)tid * G + c; int pm = 0, pn = 0, e = 0, ok = 0;
            if (L < nwg) { int wgid = (int)L; { const int q = nwg / NXCD, r = nwg % NXCD, xcd = wgid % NXCD; int off = wgid / NXCD; const int csz = q + (xcd < r ? 1 : 0);
                    if (HMODE == 2) { off += rot % csz; off = off >= csz ? off - csz : off; }
                    wgid = (xcd < r ? xcd * (q + 1) : r * (q + 1) + (xcd - r) * q) + off; }
                const int nig = MOE_WGM * nN, gid = wgid / nig, fm = gid * MOE_WGM, gsz = (nM - fm) < MOE_WGM ? (nM - fm) : MOE_WGM;
                pm = fm + ((wgid % nig) % gsz); pn = (wgid % nig) / gsz; e = ru2e[pm]; ok = 1; }
            utab[tid * 4] = pm; utab[tid * 4 + 1] = pn; utab[tid * 4 + 2] = e; utab[tid * 4 + 3] = ok; }
    }
    __device__ bool next(int i, Unit& u) const {
        if (i >= 32) return false;
        typedef int v4i_ __attribute__((ext_vector_type(4)));
        const v4i_ t = *(const PG8_LAS v4i_*)(utab + i * 4);
        if (__builtin_amdgcn_readfirstlane(t.w) == 0) return false;
        u.pm = __builtin_amdgcn_readfirstlane(t.x); u.pn = __builtin_amdgcn_readfirstlane(t.y); u.e = __builtin_amdgcn_readfirstlane(t.z); return true;
    }
    static constexpr int ALLW = 16000;
    PG8_LAS unsigned* allflag; unsigned allneed; mutable unsigned ncall;
    __device__ __forceinline__ void a_ready(const Unit& u) const {
        if constexpr (HMODE == 2) {
            const unsigned mycall = ncall++;
            if ((unsigned)__builtin_amdgcn_readfirstlane((int)*allflag) <= mycall) return;
            if (threadIdx.x < 64) { unsigned sp = 0u;
                while ((unsigned)__builtin_amdgcn_readfirstlane((int)__hip_atomic_load(cnt + 16 * u.pm, __ATOMIC_RELAXED, __HIP_MEMORY_SCOPE_AGENT)) < need) { __builtin_amdgcn_s_sleep(2); if (++sp > (1u << 21)) break; }
                const unsigned alld = (unsigned)__builtin_amdgcn_readfirstlane((int)__hip_atomic_load(cnt + ALLW, __ATOMIC_RELAXED, __HIP_MEMORY_SCOPE_AGENT));
                __builtin_amdgcn_fence(__ATOMIC_ACQUIRE, "agent");
                asm volatile("s_waitcnt vmcnt(0)" ::: "memory");
                if (alld >= allneed && threadIdx.x == 0) *allflag = mycall + 1u; }
            asm volatile("" ::: "memory"); __builtin_amdgcn_s_barrier(); asm volatile("" ::: "memory");
        }
    }
    mutable int pend;
    __device__ __forceinline__ void done(const Unit& u) const { if constexpr (HMODE == 1) { if (pend >= 0) { asm volatile("s_waitcnt vmcnt(0)" ::: "memory"); flush(); }     pend = u.pm; } }
    __device__ __forceinline__ void flush() const {
        if constexpr (HMODE == 1) { if (pend >= 0) { if ((threadIdx.x & 63) == 0) (void)__hip_atomic_fetch_add(cnt + 16 * pend, 1u, __ATOMIC_RELAXED, __HIP_MEMORY_SCOPE_AGENT); pend = -1; } }
    }
};
typedef MoeOrderT<0> MoeOrder;

typedef float f32x2_t __attribute__((ext_vector_type(2))); typedef __bf16 bf16x2_t __attribute__((ext_vector_type(2)));
__device__ __forceinline__ unsigned cvt_pk_bf16(float lo, float hi) { f32x2_t v = {lo, hi}; bf16x2_t b = __builtin_convertvector(v, bf16x2_t); return __builtin_bit_cast(unsigned, b); }
#ifndef MOE_HANDOFF
#define MOE_HANDOFF 1
#endif
#ifndef WT_STORES
#define WT_STORES 0
#endif
__device__ __forceinline__ const unsigned char* ws_base_() {
    unsigned off = 192u; asm volatile("" : "+s"(off));
    const __attribute__((address_space(4))) char* kp = (const __attribute__((address_space(4))) char*)__builtin_amdgcn_kernarg_segment_ptr();
    return (const unsigned char*)(const __attribute__((address_space(1))) void*)(*(const __attribute__((address_space(4))) unsigned long long*)(kp + off));
}
__device__ __forceinline__ __amdgpu_buffer_rsrc_t ws_rsrc_() { return __builtin_amdgcn_make_buffer_rsrc((void*)ws_base_(), 0, 0x7fffffff, 0x00020000); }
__device__ __forceinline__ int ws_off_(const void* p) { return (int)((unsigned)(size_t)p - (unsigned)(size_t)ws_base_()); }
__device__ __forceinline__ void st16_plain(void* p, u32x4 v) { *(u32x4*)p = v; }
__device__ __forceinline__ void st16_wt(void* p, u32x4 v) { __builtin_amdgcn_raw_buffer_store_b128(v, ws_rsrc_(), ws_off_(p), 0, 16); }
__device__ __forceinline__ void st16(void* p, u32x4 v) {
#if WT_STORES == 2
    __builtin_amdgcn_raw_buffer_store_b128(v, ws_rsrc_(), ws_off_(p), 0, 16);
#else
    *(u32x4*)p = v;
#endif
}
typedef unsigned u32x2s_t __attribute__((ext_vector_type(2)));
__device__ __forceinline__ void st8(void* p, u32x2s_t v) {
#if WT_STORES == 2
    __builtin_amdgcn_raw_buffer_store_b64(v, ws_rsrc_(), ws_off_(p), 0, 16);
#else
    *(u32x2s_t*)p = v;
#endif
}
__device__ __forceinline__ void st4(void* p, unsigned v) {
#if WT_STORES == 2
    __builtin_amdgcn_raw_buffer_store_b32(v, ws_rsrc_(), ws_off_(p), 0, 16);
#else
    *(unsigned*)p = v;
#endif
}
__device__ __forceinline__ void st2(void* p, unsigned short v) {
#if WT_STORES == 2
    __builtin_amdgcn_raw_buffer_store_b16(v, ws_rsrc_(), ws_off_(p), 0, 16);
#else
    *(unsigned short*)p = v;
#endif
}
__device__ __forceinline__ void st1(void* p, unsigned char v) {
#if WT_STORES == 2
    __builtin_amdgcn_raw_buffer_store_b8(v, ws_rsrc_(), ws_off_(p), 0, 16);
#else
    *(unsigned char*)p = v;
#endif
}
__device__ __forceinline__ float sigmoidf_(float x) { return __builtin_amdgcn_rcpf(1.0f + __builtin_amdgcn_exp2f(-x * LOG2E)); }

typedef int v8i_t __attribute__((ext_vector_type(8))); typedef int v4i_t __attribute__((ext_vector_type(4)));
__device__ __forceinline__ v8i_t cat8(const bf16x8& lo, const bf16x8& hi) { const v4i_t a = __builtin_bit_cast(v4i_t, lo), b = __builtin_bit_cast(v4i_t, hi); return __builtin_shufflevector(a, b, 0, 1, 2, 3, 4, 5, 6, 7); }
__device__ __forceinline__ void mfma_fp8_acc(f32x4& acc, const v8i_t a, const v8i_t b, unsigned sc) {
    asm volatile("v_mfma_scale_f32_16x16x128_f8f6f4 %0, %1, %2, %0, %3, %3 op_sel_hi:[0,0,0]" : "+v"(acc) : "v"(a), "v"(b), "v"(sc)); }
__device__ __forceinline__ float clamp448(float v) { return __builtin_amdgcn_fmed3f(v, -448.0f, 448.0f); }
__device__ __forceinline__ unsigned pk4_fp8(float a, float b, float c, float d) { unsigned w = 0u; w = __builtin_amdgcn_cvt_pk_fp8_f32(clamp448(a), clamp448(b), w, false); w = __builtin_amdgcn_cvt_pk_fp8_f32(clamp448(c), clamp448(d), w, true); return w; }
__device__ __forceinline__ unsigned pk4_fp8_nc(float a, float b, float c, float d) { unsigned w = 0u; w = __builtin_amdgcn_cvt_pk_fp8_f32(a, b, w, false); w = __builtin_amdgcn_cvt_pk_fp8_f32(c, d, w, true); return w; }
typedef unsigned u32x2_t __attribute__((ext_vector_type(2)));

struct EpiBf16 {
    static constexpr bool PERM = true, AFTER_DRAIN = false, PREFETCH = false, BPERM2 = false;
    bf16_t* O; int ldc; float scale;
    __device__ __forceinline__ void operator()(const f32x4 (&acc)[2][2][4][2], const Unit& u, int wr, int wc, int fr, int fq) const {
        const int row0 = u.pm * BM + wr * 64 + fr, col0 = u.pn * BM + wc * 32 + 8 * fq;
#pragma unroll
        for (int ai = 0; ai < 2; ++ai)
#pragma unroll
            for (int m = 0; m < 4; ++m) { bf16_t* rowp = O + (size_t)(row0 + ai * HALF + m * 16) * ldc + col0;
#pragma unroll
                for (int bj = 0; bj < 2; ++bj) { const f32x4 v0 = acc[ai][bj][m][0] * scale, v1 = acc[ai][bj][m][1] * scale;
                    u32x4 w; w.x = cvt_pk_bf16(v0[0], v0[1]); w.y = cvt_pk_bf16(v0[2], v0[3]); w.z = cvt_pk_bf16(v1[0], v1[1]); w.w = cvt_pk_bf16(v1[2], v1[3]);
                    st16(rowp + bj * HALF, w); } }
    }
};
template <int MODE> struct EpiGlu {
    static constexpr bool PERM = true, AFTER_DRAIN = false, PREFETCH = (MODE == 2), BPERM2 = false;
    bf16_t* O; const float* bias; float accs, outs; PG8_LAS float* tab;
    __device__ __forceinline__ void prefetch(const Unit& u, int par, int tid, int wid) const {
        if (wid < 4) glds4((unsigned)(tid & 63) * 4u, (const void*)(bias + (size_t)u.e * 2048 + (wid >> 1) * 1024 + u.pn * HALF + (wid & 1) * 64), (unsigned)(size_t)(tab + par * 256) + (unsigned)wid * 256u);
    }
    __device__ __forceinline__ void operator()(const f32x4 (&acc)[2][2][4][2], const Unit& u, int wr, int wc, int fr, int fq, int par = 0) const {
        const int row0 = u.pm * BM + wr * 64 + fr, j0 = u.pn * HALF + wc * 32 + 8 * fq;
        const float* bp = bias + (size_t)u.e * 2048;
        f32x4 ba[2], bg[2];
        if (MODE == 2) { const PG8_LAS float* tb = tab + par * 256 + wc * 32 + 8 * fq;
#pragma unroll
            for (int n = 0; n < 2; ++n) { ba[n] = *(const PG8_LAS f32x4*)(tb + 4 * n); bg[n] = *(const PG8_LAS f32x4*)(tb + 128 + 4 * n); } }
        else {
#pragma unroll
            for (int n = 0; n < 2; ++n) { ba[n] = *(const f32x4*)(bp + j0 + 4 * n); bg[n] = *(const f32x4*)(bp + 1024 + j0 + 4 * n); } }
        u32x2_t wprev = {0u, 0u};
#pragma unroll
        for (int ai = 0; ai < 2; ++ai)
#pragma unroll
            for (int m = 0; m < 4; ++m) { bf16_t* rowp = O + (size_t)(row0 + ai * HALF + m * 16) * 1024 + j0;
                float o[8];
#pragma unroll
                for (int n = 0; n < 2; ++n) {
                    if (MODE == 0) { const f32x4 a = acc[ai][0][m][n] * accs + ba[n], g = acc[ai][1][m][n] * accs + bg[n];
#pragma unroll
                        for (int i = 0; i < 4; ++i) o[4 * n + i] = a[i] * sigmoidf_(g[i]); }
                    else {
#pragma unroll
                        for (int q = 0; q < 2; ++q) {
                            const f32x2_t a2 = (f32x2_t){acc[ai][0][m][n][2 * q], acc[ai][0][m][n][2 * q + 1]} * accs + (f32x2_t){ba[n][2 * q], ba[n][2 * q + 1]};
                            const f32x2_t g2 = (f32x2_t){acc[ai][1][m][n][2 * q], acc[ai][1][m][n][2 * q + 1]} * accs + (f32x2_t){bg[n][2 * q], bg[n][2 * q + 1]};
                            const f32x2_t xg = {fminf(a2.x, 7.0f), fminf(a2.y, 7.0f)}, xl = {__builtin_amdgcn_fmed3f(g2.x, -7.0f, 7.0f), __builtin_amdgcn_fmed3f(g2.y, -7.0f, 7.0f)};
                            const f32x2_t t2 = xg * (-1.702f * LOG2E); const f32x2_t d2 = (f32x2_t){__builtin_amdgcn_exp2f(t2.x), __builtin_amdgcn_exp2f(t2.y)} + 1.0f;
                            const f32x2_t sg = {__builtin_amdgcn_rcpf(d2.x), __builtin_amdgcn_rcpf(d2.y)};
                            const f32x2_t r2 = (xl * outs + outs) * (xg * sg);
                            o[4 * n + 2 * q] = r2.x; o[4 * n + 2 * q + 1] = r2.y; } } }
                if (MODE == 2) { u32x2_t w; w.x = pk4_fp8_nc(o[0], o[1], o[2], o[3]); w.y = pk4_fp8_nc(o[4], o[5], o[6], o[7]);
                    if ((m & 1) == 0) wprev = w;
                    else { const auto sx = __builtin_amdgcn_permlane16_swap(wprev.x, w.x, false, false), sy = __builtin_amdgcn_permlane16_swap(wprev.y, w.y, false, false);
                        u32x4 o4; o4.x = sx[0]; o4.y = sy[0]; o4.z = sx[1]; o4.w = sy[1];
                        { void* op_ = (unsigned char*)O + (size_t)(row0 + ai * HALF + (m - 1) * 16 + ((fq & 1) ? 16 : 0)) * 1024 + u.pn * HALF + wc * 32 + 8 * (fq & ~1);
                          if (MOE_HANDOFF) st16_wt(op_, o4); else st16(op_, o4); } } }
                else { u32x4 w; w.x = cvt_pk_bf16(o[0], o[1]); w.y = cvt_pk_bf16(o[2], o[3]); w.z = cvt_pk_bf16(o[4], o[5]); w.w = cvt_pk_bf16(o[6], o[7]);
                st16(rowp, w); } }
    }
};
template <bool XBF> struct EpiResid {
    static constexpr bool PERM = true, AFTER_DRAIN = false, PREFETCH = false, BPERM2 = false;
    const void* x; bf16_t* S; const float* bias; const float* gate; float accs;
    __device__ __forceinline__ void operator()(const f32x4 (&acc)[2][2][4][2], const Unit& u, int wr, int wc, int fr, int fq) const {
        const int col0 = u.pn * BM + wc * 32 + 8 * fq, b = (u.pm * BM) >> 11;
#pragma unroll
        for (int bj = 0; bj < 2; ++bj) { const int c = col0 + bj * HALF;
            f32x4 bv[2], gv[2];
#pragma unroll
            for (int n = 0; n < 2; ++n) { bv[n] = bias ? *(const f32x4*)(bias + c + 4 * n) : (f32x4){0.f, 0.f, 0.f, 0.f}; gv[n] = *(const f32x4*)(gate + (size_t)b * 6144 + c + 4 * n) + 1.0f; }
            constexpr int NAI = XBF ? 2 : 1;
#pragma unroll
            for (int a0 = 0; a0 < 2; a0 += NAI) {
            u32x4 xr[NAI][4][XBF ? 1 : 2];
#pragma unroll
            for (int ai = 0; ai < NAI; ++ai)
#pragma unroll
                for (int m = 0; m < 4; ++m) { const size_t off = (size_t)(u.pm * BM + (a0 + ai) * HALF + wr * 64 + m * 16 + fr) * 1024 + c;
                    if (XBF) xr[ai][m][0] = *(const u32x4*)((const bf16_t*)x + off);
                    else { xr[ai][m][0] = *(const u32x4*)((const float*)x + off); xr[ai][m][XBF ? 0 : 1] = *(const u32x4*)((const float*)x + off + 4); } }
#pragma unroll
            for (int ai = 0; ai < NAI; ++ai)
#pragma unroll
                for (int m = 0; m < 4; ++m) { const size_t off = (size_t)(u.pm * BM + (a0 + ai) * HALF + wr * 64 + m * 16 + fr) * 1024 + c;
                    f32x4 x0, x1;
                    if (XBF) { const u32x4 w = xr[ai][m][0];
                        x0 = (f32x4){__uint_as_float(w.x << 16), __uint_as_float(w.x & 0xffff0000u), __uint_as_float(w.y << 16), __uint_as_float(w.y & 0xffff0000u)};
                        x1 = (f32x4){__uint_as_float(w.z << 16), __uint_as_float(w.z & 0xffff0000u), __uint_as_float(w.w << 16), __uint_as_float(w.w & 0xffff0000u)}; }
                    else { x0 = __builtin_bit_cast(f32x4, xr[ai][m][0]); x1 = __builtin_bit_cast(f32x4, xr[ai][m][XBF ? 0 : 1]); }
                    const f32x4 s0 = x0 * ALPHA_DN + gv[0] * (acc[a0 + ai][bj][m][0] * accs + bv[0]), s1 = x1 * ALPHA_DN + gv[1] * (acc[a0 + ai][bj][m][1] * accs + bv[1]);
                    u32x4 o; o.x = cvt_pk_bf16(s0[0], s0[1]); o.y = cvt_pk_bf16(s0[2], s0[3]); o.z = cvt_pk_bf16(s1[0], s1[1]); o.w = cvt_pk_bf16(s1[2], s1[3]);
                    st16(S + off, o); } } }
    }
};
#ifndef YK_FP8
#define YK_FP8 1
#endif
constexpr float YK_S = 64.0f;
struct EpiMoeOut {
    static constexpr bool PERM = true, AFTER_DRAIN = false, PREFETCH = true, BPERM2 = (YK_FP8 != 0);
    bf16_t* Y; const float* bias; const int* row_asg; const float* row_gate; float accs; PG8_LAS float* tab;
    __device__ __forceinline__ void prefetch(const Unit& u, int par, int tid, int wid) const {
        if (wid < 4) { const unsigned vo = (unsigned)(tid & 63) * 4u, dst = (unsigned)(size_t)(tab + par * 768) + (unsigned)wid * 256u;
            glds4(vo, (const void*)(bias + (size_t)u.e * 1024 + u.pn * BM + wid * 64), dst);
            glds4(vo, (const void*)(row_asg + (size_t)u.pm * BM + wid * 64), dst + 1024u);
            glds4(vo, (const void*)(row_gate + (size_t)u.pm * BM + wid * 64), dst + 2048u); }
    }
    __device__ __forceinline__ void operator()(const f32x4 (&acc)[2][2][4][2], const Unit& u, int wr, int wc, int fr, int fq, int par = 0) const {
        const PG8_LAS float* tb = tab + par * 768;
#if YK_FP8
        const int cl = wc * 64 + 16 * fq;
        f32x4 bv[4];
#pragma unroll
        for (int q = 0; q < 4; ++q) bv[q] = *(const PG8_LAS f32x4*)(tb + cl + 4 * q);
#pragma unroll
        for (int ai = 0; ai < 2; ++ai)
#pragma unroll
            for (int m = 0; m < 4; ++m) { const int rl = ai * HALF + wr * 64 + m * 16 + fr; const int drow = ((const PG8_LAS int*)tb)[256 + rl]; const float g = tb[512 + rl] * YK_S;
                if (drow >= 0) { u32x4 o;
                    { const f32x4 v = (acc[ai][0][m][0] * accs + bv[0]) * g; o.x = pk4_fp8(v[0], v[1], v[2], v[3]); }
                    { const f32x4 v = (acc[ai][0][m][1] * accs + bv[1]) * g; o.y = pk4_fp8(v[0], v[1], v[2], v[3]); }
                    { const f32x4 v = (acc[ai][1][m][0] * accs + bv[2]) * g; o.z = pk4_fp8(v[0], v[1], v[2], v[3]); }
                    { const f32x4 v = (acc[ai][1][m][1] * accs + bv[3]) * g; o.w = pk4_fp8(v[0], v[1], v[2], v[3]); }
                    st16((unsigned char*)Y + (size_t)drow * 1024 + u.pn * BM + cl, o); } }
#else
        const int col0 = u.pn * BM + wc * 32 + 8 * fq;
        int dst[2][4]; float gt[2][4];
#pragma unroll
        for (int ai = 0; ai < 2; ++ai)
#pragma unroll
            for (int m = 0; m < 4; ++m) { const int rl = ai * HALF + wr * 64 + m * 16 + fr; dst[ai][m] = ((const PG8_LAS int*)tb)[256 + rl]; gt[ai][m] = tb[512 + rl]; }
        f32x4 bv[2][2];
#pragma unroll
        for (int bj = 0; bj < 2; ++bj)
#pragma unroll
            for (int n = 0; n < 2; ++n) bv[bj][n] = *(const PG8_LAS f32x4*)(tb + wc * 32 + 8 * fq + bj * HALF + 4 * n);
#pragma unroll
        for (int ai = 0; ai < 2; ++ai)
#pragma unroll
            for (int m = 0; m < 4; ++m) {
                if (dst[ai][m] >= 0) {
#pragma unroll
                    for (int bj = 0; bj < 2; ++bj) { const f32x4 v0 = (acc[ai][bj][m][0] * accs + bv[bj][0]) * gt[ai][m], v1 = (acc[ai][bj][m][1] * accs + bv[bj][1]) * gt[ai][m];
                        u32x4 w; w.x = cvt_pk_bf16(v0[0], v0[1]); w.y = cvt_pk_bf16(v0[2], v0[3]); w.z = cvt_pk_bf16(v1[0], v1[1]); w.w = cvt_pk_bf16(v1[2], v1[3]);
                        *(u32x4*)(Y + (size_t)dst[ai][m] * 1024 + col0 + bj * HALF) = w;
                    } } }
#endif
    }
};

#ifndef PG8_B1LATE
#define PG8_B1LATE 0
#endif
template <class Epi, class Sched, bool ALIGN_EPI = false, bool SP2 = false, bool FP8 = false, bool GATHER = false>
__device__ __forceinline__ void gemm_phase(PG8_LAS unsigned char* lds, const Gemm g, const Sched& S, const Epi& E) {
    int tid_l = threadIdx.x; asm volatile("" : "+v"(tid_l));
    const int tid = tid_l, wid = __builtin_amdgcn_readfirstlane(tid >> 6), lane = tid & 63, wr = wid >> 2, wc = wid & 3, fr = lane & 15, fq = lane >> 4;
    const int K = g.K, nt = K / BK;
    unsigned voffA[2], voffB[2], voffB1[2];
#pragma unroll
    for (int i = 0; i < 2; ++i) { int R, C; stage_rc(tid * 16 + i * 8192, R, C); const int Rb = Epi::PERM ? ((R & ~31) + perm32(R & 31)) : R;
        voffA[i] = (unsigned)(R * K + C) * 2u; voffB[i] = (unsigned)(Rb * K + C) * 2u; voffB1[i] = voffB[i];
        if constexpr (Epi::BPERM2) { const int p = perm32(R & 31), Rb2 = 64 * (R >> 5) + 2 * (p & ~7) + (p & 7); voffB[i] = (unsigned)(Rb2 * K + C) * 2u; voffB1[i] = (unsigned)((Rb2 + 8) * K + C) * 2u; } }
    const size_t kstep = (size_t)(BK * 2);
    const size_t hstep = (size_t)HALF * K * 2;
    const size_t tstep = 2 * hstep;
    const unsigned ldsw = (unsigned)wid * 1024u;
    unsigned scv = 0x7f7f7f7fu; asm volatile("" : "+v"(scv));
    (void)scv;
    const unsigned ldsbase = (unsigned)__builtin_amdgcn_readfirstlane((int)((unsigned)(size_t)lds + ldsw));
    const int aoff = lds_byte(wr * 64 + fr, fq * 8), boff = lds_byte(wc * 32 + fr, fq * 8);
#define PG8_SA(b, h) (((b) * 2 + (h)) * HTB)
#define PG8_SB(b, h) ((4 + (b) * 2 + (h)) * HTB)
#define PG8_STAGE(bufoff, gbase, voff) do { glds16_i<(bufoff)>((voff)[0], (const void*)(gbase), ldsbase); glds16_i<(bufoff) + 8192>((voff)[1], (const void*)(gbase), ldsbase); } while (0)
#define PG8_LDA(dst, b, h) do { _Pragma("unroll") for (int m = 0; m < 4; ++m) _Pragma("unroll") for (int k = 0; k < 2; ++k) dst[m][k] = *(const PG8_LAS bf16x8*)(lds + PG8_SA(b, h) + aoff + m * 2048 + k * 1024); } while (0)
#define PG8_LDB(dst, b, h) do { _Pragma("unroll") for (int n = 0; n < 2; ++n) _Pragma("unroll") for (int k = 0; k < 2; ++k) dst[n][k] = *(const PG8_LAS bf16x8*)(lds + PG8_SB(b, h) + boff + n * 2048 + k * 1024); } while (0)
#define PG8_MMA(ai, bj, At, Bt) do { __builtin_amdgcn_s_setprio(1); \
        if constexpr (FP8) { _Pragma("unroll") for (int m = 0; m < 4; ++m) _Pragma("unroll") for (int n = 0; n < 2; ++n) \
            mfma_fp8_acc(acc[ai][bj][m][n], cat8(Bt[n][0], Bt[n][1]), cat8(At[m][0], At[m][1]), scv); } \
        else { _Pragma("unroll") for (int m = 0; m < 4; ++m) _Pragma("unroll") for (int n = 0; n < 2; ++n) _Pragma("unroll") for (int k = 0; k < 2; ++k) \
            acc[ai][bj][m][n] = __builtin_amdgcn_mfma_f32_16x16x32_bf16(Bt[n][k], At[m][k], acc[ai][bj][m][n], 0, 0, 0); } \
        __builtin_amdgcn_s_setprio(0); } while (0)
#define PG8_WAIT_V(n) asm volatile("s_waitcnt vmcnt(" #n ")" ::: "memory")
#define PG8_WAIT_L(n) asm volatile("s_waitcnt lgkmcnt(" #n ")" ::: "memory")
#define PG8_BAR __builtin_amdgcn_s_barrier()
#define PG8_SCHED __builtin_amdgcn_sched_barrier(0)
    Unit cur, nxt; int ui = 0;
    if (!S.next(0, cur)) return;
    f32x4 acc[2][2][4][2];
#pragma unroll
    for (int a = 0; a < 2; ++a)
#pragma unroll
        for (int b = 0; b < 2; ++b)
#pragma unroll
            for (int m = 0; m < 4; ++m)
#pragma unroll
                for (int n = 0; n < 2; ++n) acc[a][b][m][n] = (f32x4){0.f, 0.f, 0.f, 0.f};
    bf16x8 At[4][2], B0[2][2], B1[2][2];
    static_assert(!GATHER || SP2, "the gathered-A form exists for the SP2 loop only");
    const char* cA = GATHER ? (const char*)g.A : (const char*)g.A + (size_t)cur.pm * tstep; const char* cB = (const char*)g.Bt + (size_t)cur.e * g.estride + (size_t)cur.pn * tstep;
    const size_t hstepB = Epi::BPERM2 ? 0 : hstep;
    static_assert(!Epi::BPERM2 || SP2, "BPERM2 exists for the SP2 loop only");
    const size_t hstepA = GATHER ? 0 : hstep;
    unsigned cvA[2][2], nvA[2][2]; int tabi[2][2]; unsigned cofs[2];
    if constexpr (GATHER) {
#pragma unroll
        for (int i = 0; i < 2; ++i) { int R, C; stage_rc(tid * 16 + i * 8192, R, C); cofs[i] = (unsigned)C * 2u; tabi[0][i] = R; tabi[1][i] = HALF + R; }
        __syncthreads();
        if (tid < BM) g.tab[tid] = g.rowtok[cur.pm * BM + tid];
        __syncthreads();
#pragma unroll
        for (int h = 0; h < 2; ++h)
#pragma unroll
            for (int i = 0; i < 2; ++i) { cvA[h][i] = (unsigned)g.tab[tabi[h][i]] * (unsigned)(K * 2) + cofs[i]; nvA[h][i] = cvA[h][i]; }
    } else {
#pragma unroll
        for (int h = 0; h < 2; ++h)
#pragma unroll
            for (int i = 0; i < 2; ++i) { cvA[h][i] = voffA[i]; nvA[h][i] = voffA[i]; tabi[h][i] = 0; }
        cofs[0] = cofs[1] = 0u;
    }
    S.a_ready(cur);
    if constexpr (SP2) {
        PG8_STAGE(PG8_SB(0, 0), cB, voffB); PG8_STAGE(PG8_SB(0, 1), cB + hstepB, voffB1); PG8_STAGE(PG8_SA(0, 0), cA, cvA[0]); PG8_STAGE(PG8_SA(0, 1), cA + hstepA, cvA[1]);
        if (wr == 1) PG8_BAR;
        PG8_WAIT_V(2); PG8_BAR;
        PG8_STAGE(PG8_SB(1, 0), cB + kstep, voffB); PG8_STAGE(PG8_SA(1, 0), cA + kstep, cvA[0]); PG8_STAGE(PG8_SB(1, 1), cB + hstepB + kstep, voffB1);
        PG8_WAIT_V(6); PG8_BAR;
    } else {
        PG8_STAGE(PG8_SB(0, 0), cB, voffB); PG8_STAGE(PG8_SA(0, 0), cA, voffA); PG8_STAGE(PG8_SB(0, 1), cB + hstep, voffB); PG8_STAGE(PG8_SA(0, 1), cA + hstep, voffA);
        if (wr == 1) PG8_BAR;
        PG8_WAIT_V(4); PG8_BAR;
        PG8_STAGE(PG8_SB(1, 0), cB + kstep, voffB); PG8_STAGE(PG8_SA(1, 0), cA + kstep, voffA); PG8_STAGE(PG8_SB(1, 1), cB + hstep + kstep, voffB);
        PG8_WAIT_V(6); PG8_BAR;
    }
    for (;;) {
        const bool has_next = S.next(ui + 1, nxt);
        const char* nA = (has_next && !GATHER) ? (const char*)g.A + (size_t)nxt.pm * tstep : cA; const char* nB = has_next ? (const char*)g.Bt + (size_t)nxt.e * g.estride + (size_t)nxt.pn * tstep : cB;
#if defined(PROBE_KLOOP2)
        const int nt2_ = (FP8 == (PROBE_KLOOP2 == 1)) ? 2 * nt : nt;
#else
        const int nt2_ = nt;
#endif
#pragma clang loop unroll(disable)
        for (int tt_ = 0; tt_ < nt2_; tt_ += 2) {
            const int t = tt_ >= nt ? tt_ - nt : tt_;
            const bool pass_end = (t == nt - 2), last = pass_end && (tt_ == nt2_ - 2);
            const char* a1 = cA + (size_t)(t + 1) * kstep;
            const char* a2 = last ? nA : (pass_end ? cA : cA + (size_t)(t + 2) * kstep); const char* b2 = last ? nB : (pass_end ? cB : cB + (size_t)(t + 2) * kstep);
            const char* a3 = a2 + kstep; const char* b3 = b2 + kstep;
            if (last && has_next) S.a_ready(nxt);
            if constexpr (Epi::PREFETCH) { if (t == 0) E.prefetch(cur, ui & 1, tid, wid); }
            if (t == 4) S.flush();
            unsigned sA[2][2];
            if constexpr (GATHER) {
                if (t == 0 && has_next && wid < 4) glds4((unsigned)tid * 4u, (const void*)(g.rowtok + (size_t)nxt.pm * BM), (unsigned)(size_t)(g.tab + ((ui + 1) & 1) * BM) + (unsigned)wid * 256u);
                const PG8_LAS int* tb = g.tab + ((ui + 1) & 1) * BM;
                if (last && has_next) {
#pragma unroll
                    for (int h = 0; h < 2; ++h)
#pragma unroll
                        for (int i = 0; i < 2; ++i) { nvA[h][i] = (unsigned)tb[tabi[h][i]] * (unsigned)(K * 2) + cofs[i]; sA[h][i] = nvA[h][i]; } }
                else {
#pragma unroll
                    for (int h = 0; h < 2; ++h)
#pragma unroll
                        for (int i = 0; i < 2; ++i) sA[h][i] = cvA[h][i]; }
            } else {
#pragma unroll
                for (int h = 0; h < 2; ++h)
#pragma unroll
                    for (int i = 0; i < 2; ++i) sA[h][i] = voffA[i];
            }
            if constexpr (SP2) {
#if PG8_B1LATE
            PG8_LDB(B0, 0, 0); PG8_SCHED; PG8_LDA(At, 0, 0); PG8_STAGE(PG8_SA(1, 1), a1 + hstepA, cvA[1]);
            if (t == 0) {
#pragma unroll
                for (int a_ = 0; a_ < 2; ++a_)
#pragma unroll
                    for (int b_ = 0; b_ < 2; ++b_)
#pragma unroll
                        for (int m_ = 0; m_ < 4; ++m_)
#pragma unroll
                            for (int n_ = 0; n_ < 2; ++n_) acc[a_][b_][m_][n_] = (f32x4){0.f, 0.f, 0.f, 0.f}; }
            PG8_WAIT_V(8); PG8_WAIT_L(0); PG8_BAR; PG8_LDB(B1, 0, 1); PG8_SCHED; PG8_MMA(0, 0, At, B0); PG8_MMA(0, 1, At, B1); PG8_BAR; PG8_SCHED;
            PG8_LDA(At, 0, 1); PG8_STAGE(PG8_SB(0, 0), b2, voffB); PG8_STAGE(PG8_SA(0, 0), a2, sA[0]);
            PG8_WAIT_V(6); PG8_WAIT_L(0); PG8_BAR; PG8_STAGE(PG8_SB(0, 1), b2 + hstepB, voffB1); PG8_MMA(1, 0, At, B0); PG8_MMA(1, 1, At, B1); PG8_BAR; PG8_SCHED;
            PG8_LDB(B0, 1, 0); PG8_SCHED; PG8_LDA(At, 1, 0); PG8_STAGE(PG8_SA(0, 1), a2 + hstepA, sA[1]);
            PG8_WAIT_V(8); PG8_WAIT_L(0); PG8_BAR; PG8_LDB(B1, 1, 1); PG8_SCHED; PG8_MMA(0, 0, At, B0); PG8_MMA(0, 1, At, B1); PG8_BAR; PG8_SCHED;
            PG8_LDA(At, 1, 1); PG8_STAGE(PG8_SB(1, 0), b3, voffB); PG8_STAGE(PG8_SA(1, 0), a3, sA[0]);
            PG8_WAIT_V(6); PG8_WAIT_L(0); PG8_BAR; PG8_STAGE(PG8_SB(1, 1), b3 + hstepB, voffB1); PG8_MMA(1, 0, At, B0); PG8_MMA(1, 1, At, B1); PG8_BAR; PG8_SCHED;
#else
            PG8_LDB(B0, 0, 0); PG8_LDB(B1, 0, 1); PG8_SCHED; PG8_LDA(At, 0, 0); PG8_STAGE(PG8_SA(1, 1), a1 + hstepA, cvA[1]);
            if (t == 0) {
#pragma unroll
                for (int m_ = 0; m_ < 4; ++m_)
#pragma unroll
                    for (int n_ = 0; n_ < 2; ++n_) acc[0][0][m_][n_] = (f32x4){0.f, 0.f, 0.f, 0.f}; }
            PG8_WAIT_V(8); PG8_WAIT_L(0); PG8_BAR; PG8_MMA(0, 0, At, B0);
            if (t == 0) {
#pragma unroll
                for (int m_ = 0; m_ < 4; ++m_)
#pragma unroll
                    for (int n_ = 0; n_ < 2; ++n_) acc[0][1][m_][n_] = (f32x4){0.f, 0.f, 0.f, 0.f}; }
            PG8_MMA(0, 1, At, B1); PG8_BAR; PG8_SCHED;
            PG8_LDA(At, 0, 1); PG8_STAGE(PG8_SB(0, 0), b2, voffB); PG8_STAGE(PG8_SB(0, 1), b2 + hstepB, voffB1); PG8_STAGE(PG8_SA(0, 0), a2, sA[0]);
            if (t == 0) {
#pragma unroll
                for (int m_ = 0; m_ < 4; ++m_)
#pragma unroll
                    for (int n_ = 0; n_ < 2; ++n_) acc[1][0][m_][n_] = (f32x4){0.f, 0.f, 0.f, 0.f}; }
            PG8_WAIT_V(8); PG8_WAIT_L(0); PG8_BAR; PG8_MMA(1, 0, At, B0);
            if (t == 0) {
#pragma unroll
                for (int m_ = 0; m_ < 4; ++m_)
#pragma unroll
                    for (int n_ = 0; n_ < 2; ++n_) acc[1][1][m_][n_] = (f32x4){0.f, 0.f, 0.f, 0.f}; }
            PG8_MMA(1, 1, At, B1); PG8_BAR; PG8_SCHED;
            PG8_LDB(B0, 1, 0); PG8_LDB(B1, 1, 1); PG8_SCHED; PG8_LDA(At, 1, 0); PG8_STAGE(PG8_SA(0, 1), a2 + hstepA, sA[1]);
            PG8_WAIT_V(8); PG8_WAIT_L(0); PG8_BAR; PG8_MMA(0, 0, At, B0); PG8_MMA(0, 1, At, B1); PG8_BAR; PG8_SCHED;
            PG8_LDA(At, 1, 1); PG8_STAGE(PG8_SB(1, 0), b3, voffB); PG8_STAGE(PG8_SB(1, 1), b3 + hstepB, voffB1); PG8_STAGE(PG8_SA(1, 0), a3, sA[0]);
            PG8_WAIT_V(8); PG8_WAIT_L(0); PG8_BAR; PG8_MMA(1, 0, At, B0); PG8_MMA(1, 1, At, B1); PG8_BAR; PG8_SCHED;
#endif
            } else {
            PG8_LDB(B0, 0, 0); PG8_SCHED; PG8_LDA(At, 0, 0); PG8_STAGE(PG8_SA(1, 1), a1 + hstep, voffA);
            PG8_WAIT_L(8); PG8_BAR; PG8_WAIT_L(0); PG8_MMA(0, 0, At, B0); PG8_BAR; PG8_SCHED;
            PG8_LDB(B1, 0, 1); PG8_STAGE(PG8_SB(0, 0), b2, voffB);
            PG8_BAR; PG8_WAIT_L(0); PG8_MMA(0, 1, At, B1); PG8_BAR;
            PG8_LDA(At, 0, 1); PG8_STAGE(PG8_SA(0, 0), a2, voffA);
            PG8_BAR; PG8_WAIT_L(0); PG8_MMA(1, 0, At, B0); PG8_BAR; PG8_SCHED;
            PG8_STAGE(PG8_SB(0, 1), b2 + hstep, voffB);
            PG8_WAIT_V(6); PG8_BAR; PG8_MMA(1, 1, At, B1); PG8_BAR;
            PG8_LDB(B0, 1, 0); PG8_SCHED; PG8_LDA(At, 1, 0); PG8_STAGE(PG8_SA(0, 1), a2 + hstep, voffA);
            PG8_WAIT_L(8); PG8_BAR; PG8_WAIT_L(0); PG8_MMA(0, 0, At, B0); PG8_BAR; PG8_SCHED;
            PG8_LDB(B1, 1, 1); PG8_STAGE(PG8_SB(1, 0), b3, voffB);
            PG8_BAR; PG8_WAIT_L(0); PG8_MMA(0, 1, At, B1); PG8_BAR;
            PG8_LDA(At, 1, 1); PG8_STAGE(PG8_SA(1, 0), a3, voffA);
            PG8_BAR; PG8_WAIT_L(0); PG8_MMA(1, 0, At, B0); PG8_BAR; PG8_SCHED;
            PG8_STAGE(PG8_SB(1, 1), b3 + hstep, voffB);
            PG8_WAIT_V(6); PG8_BAR; PG8_MMA(1, 1, At, B1); PG8_BAR;
            }
#if defined(PROBE_KLOOP2)
            if (pass_end && !last) {
#pragma unroll
                for (int a_ = 0; a_ < 2; ++a_)
#pragma unroll
                    for (int b_ = 0; b_ < 2; ++b_)
#pragma unroll
                        for (int m_ = 0; m_ < 4; ++m_)
#pragma unroll
                            for (int n_ = 0; n_ < 2; ++n_) acc[a_][b_][m_][n_] = (f32x4){0.f, 0.f, 0.f, 0.f}; }
#endif
        }
        if constexpr (FP8) asm volatile("s_nop 15\n\ts_nop 7" ::: "memory");
        if constexpr (ALIGN_EPI) { if (wr == 0) PG8_BAR; }
        if constexpr (!Epi::AFTER_DRAIN) { int fr_e = fr, fq_e = fq; asm volatile("" : "+v"(fr_e), "+v"(fq_e));
            if constexpr (Epi::PREFETCH) E(acc, cur, wr, wc, fr_e, fq_e, ui & 1); else E(acc, cur, wr, wc, fr_e, fq_e);
#if defined(PROBE_EPI_TWICE)
            if constexpr (FP8 && !Epi::PREFETCH) { asm volatile("" : "+v"(fr_e), "+v"(fq_e)); E(acc, cur, wr, wc, fr_e, fq_e); }
#endif
            S.done(cur); }
        if (!has_next) break;
        if constexpr (!SP2)
#pragma unroll
        for (int a = 0; a < 2; ++a)
#pragma unroll
            for (int b = 0; b < 2; ++b)
#pragma unroll
                for (int m = 0; m < 4; ++m)
#pragma unroll
                    for (int n = 0; n < 2; ++n) acc[a][b][m][n] = (f32x4){0.f, 0.f, 0.f, 0.f};
        cur = nxt; cA = nA; cB = nB; ++ui;
        if constexpr (GATHER) {
#pragma unroll
            for (int h = 0; h < 2; ++h)
#pragma unroll
                for (int i = 0; i < 2; ++i) cvA[h][i] = nvA[h][i]; }
        if constexpr (ALIGN_EPI) { if (wr == 1) PG8_BAR; }
    }
    PG8_WAIT_V(0);
    S.flush();
    if constexpr (!ALIGN_EPI) { if (wr == 0) PG8_BAR; }
    PG8_BAR;
    if constexpr (Epi::AFTER_DRAIN) { E.fused(acc, cur, wr, wc, fr, fq, lds, wid, lane); S.done(cur); }
#undef PG8_SA
#undef PG8_SB
#undef PG8_STAGE
#undef PG8_LDA
#undef PG8_LDB
#undef PG8_MMA
#undef PG8_WAIT_V
#undef PG8_WAIT_L
#undef PG8_BAR
#undef PG8_SCHED
}
}

#define GAS __attribute__((address_space(1)))
#define LAS __attribute__((address_space(3)))
typedef unsigned short bf16;
typedef unsigned v4u __attribute__((ext_vector_type(4)));
typedef float f32x4 __attribute__((ext_vector_type(4)));
typedef short bf16x8 __attribute__((ext_vector_type(8)));
typedef GAS unsigned gu32;
typedef GAS unsigned long long gu64;
#define RLX_AGENT __ATOMIC_RELAXED, __HIP_MEMORY_SCOPE_AGENT
#define LDS_WAIT() asm volatile("s_waitcnt lgkmcnt(0)" ::: "memory")
#define VM_WAIT() asm volatile("s_waitcnt vmcnt(0)" ::: "memory")
__device__ __forceinline__ unsigned long long rt() { return __builtin_amdgcn_s_memrealtime(); }
__device__ __forceinline__ unsigned f2bf(float f) { unsigned u = __builtin_bit_cast(unsigned, f); return (u + 0x7fffu + ((u >> 16) & 1u)) >> 16; }
__device__ __forceinline__ unsigned pk2(float lo, float hi) { return f2bf(lo) | (f2bf(hi) << 16); }

#define XB_TMO      128
#define XB_XCNT(j)  (256  + 64 * (j))
#define XB_XSUB(j)  (1280 + 64 * (j))
#define XB_XGEN(j)  (2304 + 64 * (j))
#define XB_TOP      3328
#define XB_TOPGEN   3392
#define XCD_BAR_WORDS 3456
#define XB_SPIN_CAP (1u << 18)

__device__ __forceinline__ unsigned xb_ld(unsigned* p)              { return __hip_atomic_load(p, __ATOMIC_RELAXED, __HIP_MEMORY_SCOPE_AGENT); }
__device__ __forceinline__ unsigned xb_add(unsigned* p, unsigned v) { return __hip_atomic_fetch_add(p, v, __ATOMIC_RELAXED, __HIP_MEMORY_SCOPE_AGENT); }
__device__ __forceinline__ unsigned xb_xcc_id() { return (unsigned)__builtin_amdgcn_s_getreg((3 << 11) | 20) & 0xFu; }
#define XB_SPIN(cond, bar) do { unsigned _sp = 0; while (cond) { __builtin_amdgcn_s_sleep(1); \
    if ((++_sp & 255u) == 0u) { if (xb_ld(&(bar)[XB_TMO])) break; if (_sp > XB_SPIN_CAP) { atomicAdd(&(bar)[XB_TMO], 1u); break; } } } } while (0)

struct XcdBarrier {
    unsigned* bar; unsigned x;
    volatile LAS unsigned* st;
};

__device__ __forceinline__ XcdBarrier xcd_barrier_post(unsigned* bar, volatile LAS unsigned* st) {
    XcdBarrier b; b.bar = bar; b.x = xb_xcc_id(); b.st = st;
    if (threadIdx.x == 0) (void)xb_add(&bar[XB_XCNT(b.x)], 1u);
    return b;
}
__device__ __forceinline__ void xcd_barrier_complete(unsigned* bar, unsigned x, unsigned& nloc, unsigned& nx) {
    const unsigned G = gridDim.x * gridDim.y * gridDim.z;
    unsigned sum, cnt, mine, sp = 0u;
    for (;;) {
        sum = 0u; cnt = 0u; mine = 0u;
#pragma unroll
        for (unsigned j = 0; j < 16; ++j) { const unsigned c = xb_ld(&bar[XB_XCNT(j)]); sum += c; cnt += (c > 0u) ? 1u : 0u; mine = (j == x) ? c : mine; }
        if (sum == G) break;
        __builtin_amdgcn_s_sleep(1);
        if ((++sp & 255u) == 0u) { if (xb_ld(&bar[XB_TMO])) break; if (sp > XB_SPIN_CAP) { atomicAdd(&bar[XB_TMO], 1u); break; } }
    }
    nloc = mine > 0u ? mine : 1u; nx = cnt > 0u ? cnt : 1u;
}

__device__ __forceinline__ void xcd_barrier(const XcdBarrier& b) {
    asm volatile("s_waitcnt vmcnt(0)" ::: "memory");
    __syncthreads();
    if (threadIdx.x == 0) {
        unsigned* bar = b.bar;
        __builtin_amdgcn_s_waitcnt(0);
        unsigned nloc = b.st[0], nx = b.st[1];
        if (nloc == 0u) { xcd_barrier_complete(bar, b.x, nloc, nx); b.st[0] = nloc; b.st[1] = nx; }
        const unsigned old = xb_add(&bar[XB_XSUB(b.x)], 1u);
        const unsigned gen = old / nloc;
        if (old + 1u == (gen + 1u) * nloc) {
            __builtin_amdgcn_fence(__ATOMIC_RELEASE, "agent");
            asm volatile("s_waitcnt vmcnt(0)" ::: "memory");
            const unsigned og = xb_add(&bar[XB_TOP], 1u);
            const unsigned tg = og / nx;
            if (og + 1u == (tg + 1u) * nx) xb_add(&bar[XB_TOPGEN], 1u);
            else XB_SPIN(xb_ld(&bar[XB_TOPGEN]) == tg, bar);
            __builtin_amdgcn_fence(__ATOMIC_ACQUIRE, "agent");
            xb_add(&bar[XB_XGEN(b.x)], 1u);
            asm volatile("s_waitcnt vmcnt(0)" ::: "memory");
        } else {
            XB_SPIN(xb_ld(&bar[XB_XGEN(b.x)]) == gen, bar);
            __builtin_amdgcn_fence(__ATOMIC_ACQUIRE, "agent");
            asm volatile("s_waitcnt vmcnt(0)" ::: "memory");
        }
    }
    __syncthreads();
}

constexpr size_t MiB = 1u << 20;
constexpr size_t WS_CTL = 0, CTL_ZERO_BYTES = 160 * 1024;
constexpr size_t WS_MOD = 1 * MiB;
constexpr size_t WS_HIST = 2 * MiB;
constexpr size_t WS_META = 2 * MiB + 128 * 1024;
constexpr size_t WS_TOKE = 3 * MiB;
constexpr size_t WS_GATE = 3 * MiB + 512 * 1024;
constexpr size_t WS_RASG = 4 * MiB;
constexpr size_t WS_RGATE = 5 * MiB;
constexpr size_t WS_RWT = 7 * MiB;
constexpr size_t WS_RTOK = 6 * MiB;
constexpr size_t WS_W1T = 8 * MiB, WS_W2T = 12 * MiB, WS_KVT = 14 * MiB, WS_QT = 18 * MiB, WS_OT = 20 * MiB;
constexpr size_t WS_MIN = 24 * MiB;
constexpr size_t WS_MOUT = 280 * MiB;
constexpr size_t WS_RA = 408 * MiB;
constexpr size_t WS_RB = 680 * MiB;
constexpr size_t WS_S = 952 * MiB;
constexpr size_t WS_X = 1080 * MiB;
constexpr size_t WS_H2 = 1208 * MiB;
constexpr size_t WS_X2B = 1272 * MiB, WS_HQ = 1336 * MiB;
constexpr size_t WS_END = 1400 * MiB;
constexpr int CW_ADA = 64;
constexpr int CW_CNT = 8192, CNT_LAYER_WORDS = 16384;
static_assert((CW_CNT + 2 * CNT_LAYER_WORDS) * 4 <= (int)CTL_ZERO_BYTES && 16 * MAXRU <= CNT_LAYER_WORDS, "hand-off counters inside the per-call memset");
constexpr int CW_BAR = 4096;
static_assert((CW_BAR + 3456) * 4 <= (int)CTL_ZERO_BYTES, "barrier words inside the per-call memset");

constexpr int RING_OFF = 0, RING_BYTES = 131072;
constexpr int LDSCTL_OFF = RING_BYTES;
constexpr int LDS_BYTES = 147456;
constexpr int NWAVES = 8, NTHREADS = 512;

typedef float f32x16 __attribute__((ext_vector_type(16)));
#define CAS __attribute__((address_space(4)))
__device__ __forceinline__ const void* karg(unsigned byteoff) {
    asm volatile("" : "+s"(byteoff));
    const CAS char* kp = (const CAS char*)__builtin_amdgcn_kernarg_segment_ptr();
    const unsigned long long v = *(const CAS unsigned long long*)(kp + byteoff);
    return (const void*)(const __attribute__((address_space(1))) void*)v;
}
typedef pg8::f32x2_t f32x2_t;
typedef short s16x4 __attribute__((ext_vector_type(4)));
typedef unsigned u32x2 __attribute__((ext_vector_type(2)));

template <int CTRL> __device__ __forceinline__ float dppf(float v) { return __int_as_float(__builtin_amdgcn_update_dpp(0, __float_as_int(v), CTRL, 0xf, 0xf, false)); }
template <int CTRL> __device__ __forceinline__ int dppi(int v) { return __builtin_amdgcn_update_dpp(0, v, CTRL, 0xf, 0xf, false); }
__device__ __forceinline__ float wave_sum(float v) {
    v += dppf<0xB1>(v); v += dppf<0x4E>(v); v += dppf<0x141>(v); v += dppf<0x140>(v);
    const float s0 = __int_as_float(__builtin_amdgcn_readlane(__float_as_int(v), 0)), s1 = __int_as_float(__builtin_amdgcn_readlane(__float_as_int(v), 16));
    const float s2 = __int_as_float(__builtin_amdgcn_readlane(__float_as_int(v), 32)), s3 = __int_as_float(__builtin_amdgcn_readlane(__float_as_int(v), 48));
    return (s0 + s1) + (s2 + s3);
}
__device__ __forceinline__ float bf_lo(unsigned w) { return __uint_as_float(w << 16); }
__device__ __forceinline__ float bf_hi(unsigned w) { return __uint_as_float(w & 0xffff0000u); }
__device__ __forceinline__ unsigned pkbf(float lo, float hi) { return pg8::cvt_pk_bf16(lo, hi); }

__device__ __forceinline__ void p_ada(const float* c, const float* ada_w, const float* ada_b, float* mod, LAS unsigned char* lds, int vcu, int G, int tid, int wave, int lane) {
    LAS float* sc = (LAS float*)lds;
    LAS float* red = (LAS float*)(lds + 65536);
    constexpr int NC = 48, NJB = 6144 / NC;
    const int ln_c = lane < NC ? lane : NC - 1;
    for (int item = vcu; item < 2 * NJB; item += G) {
        const int l = item / NJB, jb = item % NJB;
        for (int idx = tid; idx < 16384; idx += NTHREADS) { const int b = idx >> 10, k = idx & 1023; const float v = c[idx]; sc[k * 16 + b] = v / (1.0f + __expf(-v)); }
        __syncthreads();
        float acc[16];
#pragma unroll
        for (int b = 0; b < 16; ++b) acc[b] = 0.f;
        const int k0 = wave * 128;
        const float* wp = ada_w + ((size_t)l * 1024 + k0) * 6144 + jb * NC + ln_c;
#pragma unroll 2
        for (int k64 = 0; k64 < 128; k64 += 64) { float wv64[64];
#pragma unroll
          for (int kk = 0; kk < 64; ++kk) wv64[kk] = wp[(size_t)(k64 + kk) * 6144];
#pragma unroll
          for (int k2 = 0; k2 < 64; ++k2) { const int kk = k64 + k2;
            const float wv = wv64[k2];
            const LAS f32x4* sp = (const LAS f32x4*)(sc + (k0 + kk) * 16);
#pragma unroll
            for (int q = 0; q < 4; ++q) { const f32x4 s4 = sp[q]; acc[4 * q] += s4[0] * wv; acc[4 * q + 1] += s4[1] * wv; acc[4 * q + 2] += s4[2] * wv; acc[4 * q + 3] += s4[3] * wv; }
          } }
#pragma unroll
        for (int b = 0; b < 16; ++b) red[(wave * 16 + b) * 64 + lane] = acc[b];
        __syncthreads();
        for (int idx = tid; idx < 1024; idx += NTHREADS) { const int b = idx >> 6, ln = idx & 63; float s = 0.f;
#pragma unroll
            for (int w = 0; w < 8; ++w) s += red[(w * 16 + b) * 64 + ln];
            if (ln < NC) mod[((size_t)l * 16 + b) * 6144 + jb * NC + ln] = s + ada_b[l * 6144 + jb * NC + ln]; }
        __syncthreads();
    }
}
__device__ __forceinline__ void transpose_item(const float* W, int K, int N, bf16* WT, bool glu, LAS float* scr, int item, int lane) {
    const int nblk = N / 32, kb = item / nblk, nb = item % nblk, k0 = 64 * kb, n0 = 32 * nb;
    const int r0 = glu ? (((n0 & 1023) >> 7) * 256 + (n0 >> 10) * 128 + (n0 & 127)) : n0;
#pragma unroll
    for (int i = 0; i < 32; ++i) { const int kk = 2 * i + (lane >> 5); scr[kk * 33 + (lane & 31)] = W[(size_t)(k0 + kk) * N + n0 + (lane & 31)]; }
    LDS_WAIT(); asm volatile("" ::: "memory");
    const int c = lane & 7;
#pragma unroll
    for (int j = 0; j < 4; ++j) { const int n = (lane >> 3) + 8 * j; const LAS float* s = scr + (8 * c) * 33 + n;
        v4u o; o.x = pkbf(s[0 * 33], s[1 * 33]); o.y = pkbf(s[2 * 33], s[3 * 33]); o.z = pkbf(s[4 * 33], s[5 * 33]); o.w = pkbf(s[6 * 33], s[7 * 33]);
        *(GAS v4u*)(WT + (size_t)(r0 + n) * K + k0 + 8 * c) = o; }
    LDS_WAIT(); asm volatile("" ::: "memory");
}
__device__ __forceinline__ void transpose_item_fp8(const float* W, int K, int N, unsigned char* WT8, bool glu, float scale, LAS float* scr, int item, int lane) {
    const int nblk = N / 32, kb = item / nblk, nb = item % nblk, k0 = 64 * kb, n0 = 32 * nb;
    const int r0 = glu ? (((n0 & 1023) >> 7) * 256 + (n0 >> 10) * 128 + (n0 & 127)) : n0;
#pragma unroll
    for (int i = 0; i < 32; ++i) { const int kk = 2 * i + (lane >> 5); scr[kk * 33 + (lane & 31)] = W[(size_t)(k0 + kk) * N + n0 + (lane & 31)]; }
    LDS_WAIT(); asm volatile("" ::: "memory");
    const int c = lane & 7;
#pragma unroll
    for (int j = 0; j < 4; ++j) { const int n = (lane >> 3) + 8 * j; const LAS float* s = scr + (8 * c) * 33 + n;
        u32x2 o; o.x = pg8::pk4_fp8(s[0 * 33] * scale, s[1 * 33] * scale, s[2 * 33] * scale, s[3 * 33] * scale); o.y = pg8::pk4_fp8(s[4 * 33] * scale, s[5 * 33] * scale, s[6 * 33] * scale, s[7 * 33] * scale);
        *(GAS u32x2*)(WT8 + (size_t)(r0 + n) * K + k0 + 8 * c) = o; }
    LDS_WAIT(); asm volatile("" ::: "memory");
}
#ifndef MOE_GATHER
#define MOE_GATHER 1
#endif
#ifndef MOE_FP8
#define MOE_FP8 1
#endif
constexpr float FP8_ACT_S = 4.0f, FP8_WIN_S = 32.0f, FP8_WOUT_S = 64.0f;
#ifndef DENSE8_QKV
#define DENSE8_QKV 1
#endif
#ifndef DENSE8_P2
#define DENSE8_P2 1
#endif
#ifndef DENSE8_P4
#define DENSE8_P4 1
#endif
#ifndef DENSE8_P12
#define DENSE8_P12 1
#endif
constexpr float DENSE8_W_S = 32.0f, DENSE8_A_S = 4.0f;
struct WPtrs { const float *w1, *w2, *kv, *q, *o, *min, *mout; bf16 *w1t, *w2t, *kvt, *qt, *ot, *mint, *moutt; };
struct CvtItem { const float* W; void* WT; int N; int k0, n0, r0; bool fp8, glu; float scale; };
#ifndef CVT_IN_CONV
#define CVT_IN_CONV 1
#endif
#ifndef CVT_WIDE
#define CVT_WIDE 1
#endif
template <int PART, bool WIDE = false> __device__ __forceinline__ bool cvt_item(const WPtrs& P, int it, CvtItem& I) {
    constexpr int I_W1 = 8 * 16, I_W2 = 8 * 8, I_KV = 8 * 16, I_Q = 8 * 8, I_O = 8 * 8, I_MIN = 8 * 16, I_MOUT = 8 * 8;
    constexpr int NM = (PART == 0 && !CVT_IN_CONV) ? 64 : 32, MI0 = PART == 0 ? 0 : 32;
    constexpr int NITEMS = (PART == 0 ? I_W1 + I_W2 + I_KV + I_Q + I_O : 0) + NM * I_MIN + NM * I_MOUT;
    if (it >= NITEMS) return false;
    int r = it; bool glu = false; I.fp8 = false; I.scale = 1.0f; size_t wt_elems = 0;
    if (r < NM * I_MIN) { const int mi = MI0 + r / I_MIN; r %= I_MIN; I.W = P.min + (size_t)mi * 1024 * 2048; I.N = 2048; glu = true; wt_elems = (size_t)mi * 2048 * 1024; I.WT = P.mint; I.fp8 = MOE_FP8; I.scale = MOE_FP8 ? FP8_WIN_S : 1.0f; }
    else { r -= NM * I_MIN;
      if (r < NM * I_MOUT) { const int mi = MI0 + r / I_MOUT; r %= I_MOUT; I.W = P.mout + (size_t)mi * 1024 * 1024; I.N = 1024; wt_elems = (size_t)mi * 1024 * 1024; I.WT = P.moutt; I.fp8 = MOE_FP8; I.scale = MOE_FP8 ? FP8_WOUT_S : 1.0f; }
      else { r -= NM * I_MOUT;
        if (r < I_W1) { I.W = P.w1; I.N = 2048; glu = true; I.WT = P.w1t; if (DENSE8_P2) { I.fp8 = true; I.scale = DENSE8_W_S; } }
        else { r -= I_W1; if (r < I_W2) { I.W = P.w2; I.N = 1024; I.WT = P.w2t; if (DENSE8_P4) { I.fp8 = true; I.scale = DENSE8_W_S; } }
          else { r -= I_W2; if (r < I_KV) { I.W = P.kv; I.N = 2048; I.WT = P.kvt; if (DENSE8_QKV) { I.fp8 = true; I.scale = DENSE8_W_S; } }
            else { r -= I_KV; if (r < I_Q) { I.W = P.q; I.N = 1024; I.WT = P.qt; if (DENSE8_QKV) { I.fp8 = true; I.scale = DENSE8_W_S; } } else { r -= I_Q; I.W = P.o; I.N = 1024; I.WT = P.ot; if (DENSE8_P12) { I.fp8 = true; I.scale = DENSE8_W_S; } } } } } } }
    if (WIDE) { const int nblk = I.N / 256, kb = r / nblk, nb = r % nblk; I.k0 = 64 * kb; I.n0 = 256 * nb; }
    else { const int nblk = I.N / 128, kb = r / nblk, nb = r % nblk; I.k0 = 128 * kb; I.n0 = 128 * nb; }
    I.r0 = glu ? (((I.n0 & 1023) >> 7) * 256 + (I.n0 >> 10) * 128) : I.n0;
    I.glu = glu;
    I.WT = (void*)((unsigned char*)I.WT + wt_elems * (I.fp8 ? 1 : 2));
    return true;
}
__device__ __forceinline__ void cvt_dma(const CvtItem& I, unsigned ldsbase  , int wave, int lane) {
    const unsigned rowb = (unsigned)I.N * 4u;
    const void* sb = (const void*)I.W;
#if CVT_WIDE
    const unsigned vb = (unsigned)(I.k0 + wave) * rowb + (unsigned)I.n0 * 4u + (unsigned)lane * 16u;
    pg8::glds16_i<0 * 8192>(vb + 0u * 8u * rowb, sb, ldsbase); pg8::glds16_i<1 * 8192>(vb + 1u * 8u * rowb, sb, ldsbase); pg8::glds16_i<2 * 8192>(vb + 2u * 8u * rowb, sb, ldsbase); pg8::glds16_i<3 * 8192>(vb + 3u * 8u * rowb, sb, ldsbase);
    pg8::glds16_i<4 * 8192>(vb + 4u * 8u * rowb, sb, ldsbase); pg8::glds16_i<5 * 8192>(vb + 5u * 8u * rowb, sb, ldsbase); pg8::glds16_i<6 * 8192>(vb + 6u * 8u * rowb, sb, ldsbase); pg8::glds16_i<7 * 8192>(vb + 7u * 8u * rowb, sb, ldsbase);
#else
    const unsigned p = (unsigned)(lane & 31);
    const unsigned vb = (unsigned)(I.k0 + 2 * wave + (lane >> 5)) * rowb + (unsigned)I.n0 * 4u;
    pg8::glds16_i<0 * 8192>(vb + 0u * 16u * rowb + ((p ^ 0u) << 4), sb, ldsbase);  pg8::glds16_i<1 * 8192>(vb + 1u * 16u * rowb + ((p ^ 0u) << 4), sb, ldsbase);
    pg8::glds16_i<2 * 8192>(vb + 2u * 16u * rowb + ((p ^ 4u) << 4), sb, ldsbase);  pg8::glds16_i<3 * 8192>(vb + 3u * 16u * rowb + ((p ^ 4u) << 4), sb, ldsbase);
    pg8::glds16_i<4 * 8192>(vb + 4u * 16u * rowb + ((p ^ 8u) << 4), sb, ldsbase);  pg8::glds16_i<5 * 8192>(vb + 5u * 16u * rowb + ((p ^ 8u) << 4), sb, ldsbase);
    pg8::glds16_i<6 * 8192>(vb + 6u * 16u * rowb + ((p ^ 12u) << 4), sb, ldsbase); pg8::glds16_i<7 * 8192>(vb + 7u * 16u * rowb + ((p ^ 12u) << 4), sb, ldsbase);
#endif
}
__device__ __forceinline__ void cvt_tile_out(const CvtItem& I, const LAS unsigned char* tile, int tid) {
#if CVT_WIDE
    const int sn = tid >> 1, skq = tid & 1;
    const LAS float* tp = (const LAS float*)(tile + (unsigned)(32 * skq) * 1024u + (unsigned)(sn << 2));
    constexpr int JS = 256;
    const int orow = I.r0 + (sn & 127) + (sn >> 7) * (I.glu ? 256 : 128);
#else
    const int sn = tid >> 2, skq = tid & 3;
    const LAS float* tp = (const LAS float*)(tile + (unsigned)(32 * skq) * 512u + (unsigned)((((sn >> 2) ^ (skq << 2)) << 4) + ((sn & 3) << 2)));
    constexpr int JS = 128;
    const int orow = I.r0 + sn;
#endif
    float v[32];
#pragma unroll
    for (int j = 0; j < 32; ++j) v[j] = tp[j * JS] * I.scale;
    v4u o0, o1;
    o0.x = pg8::pk4_fp8(v[0], v[1], v[2], v[3]); o0.y = pg8::pk4_fp8(v[4], v[5], v[6], v[7]); o0.z = pg8::pk4_fp8(v[8], v[9], v[10], v[11]); o0.w = pg8::pk4_fp8(v[12], v[13], v[14], v[15]);
    o1.x = pg8::pk4_fp8(v[16], v[17], v[18], v[19]); o1.y = pg8::pk4_fp8(v[20], v[21], v[22], v[23]); o1.z = pg8::pk4_fp8(v[24], v[25], v[26], v[27]); o1.w = pg8::pk4_fp8(v[28], v[29], v[30], v[31]);
    unsigned char* op = (unsigned char*)I.WT + (size_t)orow * 1024 + I.k0 + 32 * skq;
    pg8::st16(op, o0); pg8::st16(op + 16, o1);
}
__device__ __forceinline__ void p_convert(const WPtrs& P, LAS unsigned char* lds, int vcu, int G, int tid) {
#if CVT_WIDE
    constexpr int PT = 260;
    LAS float* tile = (LAS float*)lds;
    const int lr = tid >> 6, lc = tid & 63;
    const int sn = tid >> 1, skq = tid & 1;
    constexpr int RS = 8;
#else
    constexpr int PT = 132;
    LAS float* tile = (LAS float*)lds;
    const int lr = tid >> 5, lc = tid & 31;
    const int sn = tid >> 2, skq = tid & 3;
    constexpr int RS = 16;
#endif
    CvtItem cur, nxt; f32x4 reg[8];
    bool have = cvt_item<0, CVT_WIDE != 0>(P, vcu, cur);
    if (have) {
#pragma unroll
        for (int i = 0; i < 8; ++i) reg[i] = *(const f32x4*)(cur.W + (size_t)(cur.k0 + lr + RS * i) * cur.N + cur.n0 + 4 * lc); }
    for (int it = vcu; have; it += G) {
        __syncthreads();
#pragma unroll
        for (int i = 0; i < 8; ++i) *(LAS f32x4*)(tile + (lr + RS * i) * PT + 4 * lc) = reg[i];
        __syncthreads();
        const bool hn = cvt_item<0, CVT_WIDE != 0>(P, it + G, nxt);
        if (hn) {
#pragma unroll
            for (int i = 0; i < 8; ++i) reg[i] = *(const f32x4*)(nxt.W + (size_t)(nxt.k0 + lr + RS * i) * nxt.N + nxt.n0 + 4 * lc); }
        float v[32];
#pragma unroll
        for (int j = 0; j < 32; ++j) v[j] = tile[(32 * skq + j) * PT + sn] * cur.scale;
        const int orow = CVT_WIDE ? cur.r0 + (sn & 127) + (sn >> 7) * (cur.glu ? 256 : 128) : cur.r0 + sn;
        if (cur.fp8) { v4u o0, o1;
            o0.x = pg8::pk4_fp8(v[0], v[1], v[2], v[3]); o0.y = pg8::pk4_fp8(v[4], v[5], v[6], v[7]); o0.z = pg8::pk4_fp8(v[8], v[9], v[10], v[11]); o0.w = pg8::pk4_fp8(v[12], v[13], v[14], v[15]);
            o1.x = pg8::pk4_fp8(v[16], v[17], v[18], v[19]); o1.y = pg8::pk4_fp8(v[20], v[21], v[22], v[23]); o1.z = pg8::pk4_fp8(v[24], v[25], v[26], v[27]); o1.w = pg8::pk4_fp8(v[28], v[29], v[30], v[31]);
            unsigned char* op = (unsigned char*)cur.WT + (size_t)orow * 1024 + cur.k0 + 32 * skq;
            pg8::st16(op, o0); pg8::st16(op + 16, o1);
        } else { bf16* op = (bf16*)cur.WT + (size_t)orow * 1024 + cur.k0 + 32 * skq;
#pragma unroll
            for (int q = 0; q < 4; ++q) { v4u o; o.x = pkbf(v[8 * q], v[8 * q + 1]); o.y = pkbf(v[8 * q + 2], v[8 * q + 3]); o.z = pkbf(v[8 * q + 4], v[8 * q + 5]); o.w = pkbf(v[8 * q + 6], v[8 * q + 7]);
                pg8::st16(op + 8 * q, o); } }
        cur = nxt; have = hn;
    }
    __syncthreads();
}
__device__ __forceinline__ void p_modulate(const float* x, const float* modl, bf16* hA, int vcu, int G, int wave, int lane) {
    const int gw = vcu * NWAVES + wave, NGW = G * NWAVES, RPW = (T + NGW - 1) / NGW;
    const int m0 = gw * RPW, m1 = (m0 + RPW) < T ? (m0 + RPW) : T;
    if (m0 < m1) {
    f32x4 nx[4];
#pragma unroll
    for (int j = 0; j < 4; ++j) nx[j] = *(const f32x4*)(x + (size_t)m0 * D + 256 * j + 4 * lane);
    f32x4 SC[4], SH[4]; int bcur = -1;
    for (int m = m0; m < m1; ++m) {
        const int b = m >> 11;
        if (b != bcur) { bcur = b; const float* sh = modl + (size_t)b * 6144; const float* sc = sh + 1024;
#pragma unroll
            for (int j = 0; j < 4; ++j) { const int c = 256 * j + 4 * lane; SC[j] = *(const f32x4*)(sc + c) + 1.0f; SH[j] = *(const f32x4*)(sh + c); } }
        f32x4 v[4];
#pragma unroll
        for (int j = 0; j < 4; ++j) v[j] = nx[j];
        if (m + 1 < m1) {
#pragma unroll
            for (int j = 0; j < 4; ++j) nx[j] = *(const f32x4*)(x + (size_t)(m + 1) * D + 256 * j + 4 * lane); }
#pragma unroll
        for (int j = 0; j < 4; ++j) { const int c = 256 * j + 4 * lane;
            const f32x4 h = v[j] * SC[j] + SH[j];
#if DENSE8_P2
            pg8::st4((unsigned char*)hA + (size_t)m * D + c, pg8::pk4_fp8(h[0] * DENSE8_A_S, h[1] * DENSE8_A_S, h[2] * DENSE8_A_S, h[3] * DENSE8_A_S)); }
#else
            u32x2 w; w.x = pkbf(h[0], h[1]); w.y = pkbf(h[2], h[3]); pg8::st8(hA + (size_t)m * D + c, w); }
#endif
    }
    }
}
__device__ __forceinline__ void p_conv(const bf16* glu, const float* dw, const float* db, const float* lg, const float* lb, bf16* u2, LAS unsigned char* lds, int vcu, int G, int tid, int wave, int lane, const WPtrs& P) {
    const int c0 = 2 * tid;
    f32x2_t wt[CONVW];
#pragma unroll
    for (int w = 0; w < CONVW; ++w) wt[w] = *(const f32x2_t*)(dw + w * D + c0);
    const f32x2_t dbv = *(const f32x2_t*)(db + c0), lgv = *(const f32x2_t*)(lg + c0), lbv = *(const f32x2_t*)(lb + c0);
#if CVT_IN_CONV && MOE_FP8
    LAS float* red = (LAS float*)(lds + LDSCTL_OFF + 4096);
    int cvt_next = vcu; CvtItem ccur, cnxt; int cpar = 0;
    const unsigned cv_lds = (unsigned)__builtin_amdgcn_readfirstlane((int)((unsigned)(size_t)lds + (unsigned)wave * 1024u));
    bool chc = cvt_item<1, CVT_WIDE != 0>(P, cvt_next, ccur);
    if (chc) cvt_dma(ccur, cv_lds, wave, lane);
#else
    LAS float* red = (LAS float*)lds;
#endif
    constexpr int TB = 8, NWIN = TB + CONVW - 1;
    constexpr int NU = T / TB, UPB = SEQ / TB;
    unsigned wn[NWIN];
    if (vcu < NU) { const int u = vcu; const int b = u / UPB, t0 = (u % UPB) * TB; const bf16* rowp = glu + ((ptrdiff_t)(b * SEQ + t0) - (CONVW - 1)) * D + c0;
#pragma unroll
      for (int j = 0; j < NWIN; ++j) wn[j] = *(const unsigned*)(rowp + (ptrdiff_t)j * D); }
    for (int u = vcu; u < NU; u += G) {
        const int b = u / UPB, t0 = (u % UPB) * TB;
        f32x2_t win[NWIN];
#pragma unroll
        for (int j = 0; j < NWIN; ++j) win[j] = (f32x2_t){bf_lo(wn[j]), bf_hi(wn[j])};
        if (t0 < CONVW - 1) {
#pragma unroll
            for (int j = 0; j < NWIN; ++j) if (t0 - (CONVW - 1) + j < 0) win[j] = (f32x2_t){0.f, 0.f}; }
        { const int un = u + G; const int bn = un / UPB, tn = (un % UPB) * TB;
          if (un < NU) { const bf16* rowp = glu + ((ptrdiff_t)(bn * SEQ + tn) - (CONVW - 1)) * D + c0;
#pragma unroll
              for (int j = 0; j < NWIN; ++j) wn[j] = *(const unsigned*)(rowp + (ptrdiff_t)j * D); } }
#if CVT_IN_CONV && MOE_FP8
        bool chn = false;
        if (chc) { chn = cvt_item<1, CVT_WIDE != 0>(P, cvt_next + G, cnxt); if (chn) cvt_dma(cnxt, cv_lds + (unsigned)(cpar ^ 1) * 65536u, wave, lane); }
#endif
        f32x2_t o[TB]; float st[2 * TB];
#pragma unroll
        for (int i = 0; i < TB; ++i) { f32x2_t a = dbv;
#pragma unroll
            for (int w = 0; w < CONVW; ++w) a = win[i + w] * wt[w] + a;
            o[i] = a; st[i] = a.x + a.y; st[TB + i] = a.x * a.x + a.y * a.y; }
        float a8[8], a4[4], a2[2], a1;
#pragma unroll
        for (int k = 0; k < 8; ++k) { const auto sw2 = __builtin_amdgcn_permlane32_swap(__float_as_uint(st[k]), __float_as_uint(st[k + 8]), false, false); a8[k] = __uint_as_float(sw2[0]) + __uint_as_float(sw2[1]); }
#pragma unroll
        for (int k = 0; k < 4; ++k) { const auto sw2 = __builtin_amdgcn_permlane16_swap(__float_as_uint(a8[k]), __float_as_uint(a8[k + 4]), false, false); a4[k] = __uint_as_float(sw2[0]) + __uint_as_float(sw2[1]); }
        { const bool up = (lane & 8) != 0;
#pragma unroll
          for (int k = 0; k < 2; ++k) { const float keep = up ? a4[k + 2] : a4[k], send = up ? a4[k] : a4[k + 2]; a2[k] = keep + dppf<0x140>(send); } }
        { const bool up = (lane & 4) != 0; const float keep = up ? a2[1] : a2[0], send = up ? a2[0] : a2[1]; a1 = keep + dppf<0x141>(send); }
        a1 += dppf<0x4E>(a1); a1 += dppf<0xB1>(a1);
        if ((lane & 3) == 0) red[wave * 16 + (lane >> 2)] = a1;
#if CVT_IN_CONV && MOE_FP8
        if (chn) asm volatile("s_waitcnt vmcnt(8)" ::: "memory"); else asm volatile("s_waitcnt vmcnt(0)" ::: "memory");
#endif
        __syncthreads();
        float tot = 0.f;
        if (lane < 16) {
#pragma unroll
            for (int w = 0; w < 8; ++w) tot += red[w * 16 + lane]; }
        const float totq = __shfl(tot, (lane + 8) & 63);
        const float mean_l = tot * (1.0f / D), rstd_l = 1.0f / sqrtf(fmaxf(totq * (1.0f / D) - mean_l * mean_l, 0.f) + LN_EPS);
#pragma unroll
        for (int i = 0; i < TB; ++i) { const float mean = __int_as_float(__builtin_amdgcn_readlane(__float_as_int(mean_l), i)), rstd = __int_as_float(__builtin_amdgcn_readlane(__float_as_int(rstd_l), i));
            const f32x2_t rg = lgv * rstd, cc = lbv - rg * mean, yv = o[i] * rg + cc;
            float y0 = yv.x, y1 = yv.y;
            y0 = y0 * pg8::sigmoidf_(y0); y1 = y1 * pg8::sigmoidf_(y1);
#if DENSE8_P4
            { unsigned w8 = 0u; w8 = __builtin_amdgcn_cvt_pk_fp8_f32(pg8::clamp448(y0 * DENSE8_A_S), pg8::clamp448(y1 * DENSE8_A_S), w8, false);
              pg8::st2((unsigned char*)u2 + ((size_t)(b * SEQ + t0 + i)) * D + c0, (unsigned short)w8); } }
#else
            pg8::st4(u2 + ((size_t)(b * SEQ + t0 + i)) * D + c0, pkbf(y0, y1)); }
#endif
#if CVT_IN_CONV && MOE_FP8
        if (chc) cvt_tile_out(ccur, lds + cpar * 65536, tid);
        ccur = cnxt; chc = chn; cpar ^= 1; cvt_next += G;
#endif
        __syncthreads();
    }
#if CVT_IN_CONV && MOE_FP8
    while (chc) {
        bool chn = cvt_item<1, CVT_WIDE != 0>(P, cvt_next + G, cnxt); if (chn) cvt_dma(cnxt, cv_lds + (unsigned)(cpar ^ 1) * 65536u, wave, lane);
        if (chn) asm volatile("s_waitcnt vmcnt(8)" ::: "memory"); else asm volatile("s_waitcnt vmcnt(0)" ::: "memory");
        __syncthreads();
        cvt_tile_out(ccur, lds + cpar * 65536, tid);
        ccur = cnxt; chc = chn; cpar ^= 1; cvt_next += G;
        __syncthreads();
    }
#endif
}
__device__ __forceinline__ void p_router(const bf16* S, const float* lng, const float* lnb, const float* modl, const float* rw, const float* rb, bf16* X, bf16* H2,
                                         int* tok_e, float* gates, int* wg_hist, LAS unsigned char* lds, LAS unsigned* hist, int vcu, int G, int tid, int wave, int lane) {
    for (int idx = tid; idx < 8192; idx += NTHREADS) { const int c = idx >> 3, g = idx & 7; const f32x4 v = *(const f32x4*)(rw + c * 32 + 4 * g);
        *(LAS f32x4*)(lds + c * 128 + ((g ^ ((c >> 2) & 7)) << 4)) = v; }
    if (tid < 32) hist[tid] = 0u;
    __syncthreads();
    const int gw = vcu * NWAVES + wave, NGW = G * NWAVES;
    const int tt_me = lane >> 4, sub = (lane >> 2) & 3;
    u32x2 pre[4][4];
    if (gw < T / 4) {
#pragma unroll
        for (int tt = 0; tt < 4; ++tt)
#pragma unroll
            for (int j = 0; j < 4; ++j) pre[tt][j] = *(const u32x2*)(S + (size_t)(gw * 4 + tt) * D + 256 * j + 4 * lane); }
    for (int grp = gw; grp < T / 4; grp += NGW) {
        const int m0 = grp * 4, b = m0 >> 11;
        const float* sh2 = modl + (size_t)b * 6144 + 3 * 1024; const float* sc2 = sh2 + 1024;
        float hv[4][16];
#pragma unroll
        for (int tt = 0; tt < 4; ++tt) { const int m = m0 + tt;
            f32x4 v[4]; float s = 0.f;
#pragma unroll
            for (int j = 0; j < 4; ++j) { const u32x2 w = pre[tt][j]; v[j] = (f32x4){bf_lo(w.x), bf_hi(w.x), bf_lo(w.y), bf_hi(w.y)}; s += (v[j][0] + v[j][1]) + (v[j][2] + v[j][3]); }
            const float mean = wave_sum(s) * (1.0f / D); float q = 0.f;
#pragma unroll
            for (int j = 0; j < 4; ++j) { v[j] = v[j] - mean; q += (v[j][0] * v[j][0] + v[j][1] * v[j][1]) + (v[j][2] * v[j][2] + v[j][3] * v[j][3]); }
            const float rstd = 1.0f / sqrtf(wave_sum(q) * (1.0f / D) + LN_EPS);
#pragma unroll
            for (int j = 0; j < 4; ++j) { const int c = 256 * j + 4 * lane;
                const f32x4 x1 = v[j] * rstd * *(const f32x4*)(lng + c) + *(const f32x4*)(lnb + c);
                { u32x2 w; w.x = pkbf(x1[0], x1[1]); w.y = pkbf(x1[2], x1[3]); pg8::st8(X + (size_t)m * D + c, w); }
                const f32x4 h = x1 * (*(const f32x4*)(sc2 + c) + 1.0f) + *(const f32x4*)(sh2 + c);
#if MOE_FP8
                pg8::st4((unsigned char*)H2 + (size_t)m * D + c, pg8::pk4_fp8(h[0] * FP8_ACT_S, h[1] * FP8_ACT_S, h[2] * FP8_ACT_S, h[3] * FP8_ACT_S));
#else
                u32x2 w; w.x = pkbf(h[0], h[1]); w.y = pkbf(h[2], h[3]); *(u32x2*)(H2 + (size_t)m * D + c) = w;
#endif
                hv[tt][4 * j] = h[0]; hv[tt][4 * j + 1] = h[1]; hv[tt][4 * j + 2] = h[2]; hv[tt][4 * j + 3] = h[3]; }
            asm volatile("" ::: "memory");
        }
        if (grp + NGW < T / 4) {
#pragma unroll
            for (int tt = 0; tt < 4; ++tt)
#pragma unroll
                for (int j = 0; j < 4; ++j) pre[tt][j] = *(const u32x2*)(S + (size_t)((grp + NGW) * 4 + tt) * D + 256 * j + 4 * lane); }
        float lg[8];
#pragma unroll
        for (int g = 0; g < 8; ++g) lg[g] = 0.f;
#pragma unroll 2
        for (int g = 0; g < 8; ++g) {
            f32x2_t p2[8];
#pragma unroll
            for (int k = 0; k < 8; ++k) p2[k] = (f32x2_t){0.f, 0.f};
            const int sw = (g ^ (lane & 7)) << 4;
#pragma unroll
            for (int j = 0; j < 4; ++j)
#pragma unroll
                for (int i = 0; i < 4; ++i) { const int c = 256 * j + 4 * lane + i;
                    const f32x4 w4 = *(const LAS f32x4*)(lds + c * 128 + sw); const f32x2_t wlo = {w4[0], w4[1]}, whi = {w4[2], w4[3]};
#pragma unroll
                    for (int tt = 0; tt < 4; ++tt) { const float hx = hv[tt][4 * j + i]; const f32x2_t hh = {hx, hx}; p2[tt * 2] = hh * wlo + p2[tt * 2]; p2[tt * 2 + 1] = hh * whi + p2[tt * 2 + 1]; } }
            float p[16];
#pragma unroll
            for (int k = 0; k < 8; ++k) { p[2 * k] = p2[k].x; p[2 * k + 1] = p2[k].y; }
            float a8[8], a4[4], a2[2], a1;
#pragma unroll
            for (int k = 0; k < 8; ++k) { const auto sw2 = __builtin_amdgcn_permlane32_swap(__float_as_uint(p[k]), __float_as_uint(p[k + 8]), false, false); a8[k] = __uint_as_float(sw2[0]) + __uint_as_float(sw2[1]); }
#pragma unroll
            for (int k = 0; k < 4; ++k) { const auto sw2 = __builtin_amdgcn_permlane16_swap(__float_as_uint(a8[k]), __float_as_uint(a8[k + 4]), false, false); a4[k] = __uint_as_float(sw2[0]) + __uint_as_float(sw2[1]); }
            { const bool up = (lane & 8) != 0;
#pragma unroll
              for (int k = 0; k < 2; ++k) { const float keep = up ? a4[k + 2] : a4[k], send = up ? a4[k] : a4[k + 2]; a2[k] = keep + dppf<0x140>(send); } }
            { const bool up = (lane & 4) != 0; const float keep = up ? a2[1] : a2[0], send = up ? a2[0] : a2[1]; a1 = keep + dppf<0x141>(send); }
            a1 += dppf<0x4E>(a1); a1 += dppf<0xB1>(a1);
            a1 += rb[4 * g + sub];
#pragma unroll
            for (int gg = 0; gg < 8; ++gg) lg[gg] = (gg == g) ? a1 : lg[gg];
        }
        float tv[4]; int te[4];
#pragma unroll
        for (int k = 0; k < 4; ++k) {
            float bv = lg[0]; int be = sub;
#pragma unroll
            for (int g = 1; g < 8; ++g) { const bool better = lg[g] > bv; bv = better ? lg[g] : bv; be = better ? 4 * g + sub : be; }
            { const float ov = dppf<0x141>(bv); const int oe = dppi<0x141>(be); const bool better = (ov > bv) || (ov == bv && oe < be); bv = better ? ov : bv; be = better ? oe : be; }
            { const float ov = dppf<0x140>(bv); const int oe = dppi<0x140>(be); const bool better = (ov > bv) || (ov == bv && oe < be); bv = better ? ov : bv; be = better ? oe : be; }
            tv[k] = bv; te[k] = be;
#pragma unroll
            for (int g = 0; g < 8; ++g) lg[g] = (4 * g + sub == be) ? -INFINITY : lg[g];
        }
        const float e1 = __expf(tv[1] - tv[0]), e2 = __expf(tv[2] - tv[0]), e3 = __expf(tv[3] - tv[0]), inv = 1.0f / (1.0f + e1 + e2 + e3);
        const int kk = lane & 15;
        if (kk < 4) { const int e = kk == 0 ? te[0] : kk == 1 ? te[1] : kk == 2 ? te[2] : te[3]; const float gt = (kk == 0 ? 1.0f : kk == 1 ? e1 : kk == 2 ? e2 : e3) * inv;
            const unsigned lpos = atomicAdd((unsigned*)(hist + e), 1u);
            const int a = (m0 + tt_me) * 4 + kk; tok_e[a] = e | (int)(lpos << 8); gates[a] = gt; }
    }
    __syncthreads();
    if (tid < 32) wg_hist[vcu * 32 + tid] = (int)hist[tid];
}
#ifndef FINAL_FROM_S
#define FINAL_FROM_S 1
#endif
#ifndef ROUTER_MFMA
#define ROUTER_MFMA 1
#endif
__device__ __forceinline__ void p_rwt(const float* router_w, bf16* rwt, int vcu, int G, int tid) {
    for (int idx = vcu * NTHREADS + tid; idx < 2 * NE * D; idx += G * NTHREADS) { const int l = idx >> 15, e = (idx >> 10) & 31, ch = idx & 1023;
        const float w = router_w[((size_t)l * D + ch) * NE + e]; const unsigned hi = pkbf(w, 0.f) & 0xffffu; const float r = w - __uint_as_float(hi << 16);
        rwt[((size_t)(l * 2 + 0) * NE + e) * D + ch] = (bf16)hi; rwt[((size_t)(l * 2 + 1) * NE + e) * D + ch] = (bf16)(pkbf(r, 0.f) & 0xffffu); }
}
__device__ __forceinline__ void best2(float& bv, int& be, float ov, int oe) { const bool better = (ov > bv) || (ov == bv && oe < be); bv = better ? ov : bv; be = better ? oe : be; }
__device__ __forceinline__ void p_router_mfma(const bf16* S, const float* lng, const float* lnb, const float* modl, const bf16* rwt, const float* rb, bf16* X, bf16* H2,
                                              int* tok_e, float* gates, int* wg_hist, LAS unsigned char* lds, LAS unsigned* hist, int vcu, int G, int tid, int wave, int lane) {
    { v4u wv[16];
#pragma unroll
      for (int q = 0; q < 16; ++q) wv[q] = *(const v4u*)(rwt + (size_t)(tid + q * NTHREADS) * 8);
#pragma unroll
      for (int q = 0; q < 16; ++q) { const int idx = tid + q * NTHREADS, p = idx >> 12, e = (idx >> 7) & 31, ch = idx & 127; *(LAS v4u*)(lds + p * 65536 + e * 2048 + ((ch ^ (e & 15)) << 4)) = wv[q]; } }
    if (tid < 32) hist[tid] = 0u;
    __syncthreads();
    const int gw = vcu * NWAVES + wave, NGW = G * NWAVES, tk = lane & 15, kg = lane >> 4;
    static_assert(FINAL_FROM_S != 0, "the folded form does not produce x1");
    LAS float* gcb = (LAS float*)(lds + LDSCTL_OFF + 4096);
    int bcur = -1;
    for (int task = gw; task < T / 16; task += NGW) {
        const int m = task * 16 + tk, b = (task * 16) >> 11; const bf16* Sp = S + (size_t)m * D + 8 * kg; unsigned char* Hp = (unsigned char*)H2 + (size_t)m * (MOE_FP8 ? D : 2 * D) + (MOE_FP8 ? 8 : 16) * kg;
        v4u raw[2][8];
#pragma unroll
        for (int s = 0; s < 8; ++s) raw[0][s] = *(const v4u*)(Sp + 32 * s);
        if (b != bcur) { bcur = b; __syncthreads();
            { const int c = 2 * tid; const float* sh2 = modl + (size_t)b * 6144 + 3 * 1024; const float* sc2 = sh2 + 1024;
              const f32x2_t g2 = *(const f32x2_t*)(lng + c), b2 = *(const f32x2_t*)(lnb + c), s2 = *(const f32x2_t*)(sc2 + c) + 1.0f, h2 = *(const f32x2_t*)(sh2 + c);
              *(LAS f32x2_t*)(gcb + c) = g2 * s2; *(LAS f32x2_t*)(gcb + 1024 + c) = b2 * s2 + h2; }
            __syncthreads(); }
        float sum = 0.f, sq = 0.f;
#pragma unroll
        for (int g = 0; g < 4; ++g) {
            if (g < 3) {
#pragma unroll
                for (int s = 0; s < 8; ++s) raw[(g + 1) & 1][s] = *(const v4u*)(Sp + 32 * (8 * (g + 1) + s)); }
            else {
#pragma unroll
                for (int s = 0; s < 8; ++s) raw[(g + 1) & 1][s] = *(const v4u*)(Sp + 32 * s); }
#pragma unroll
            for (int s = 0; s < 8; ++s) { const v4u w = raw[g & 1][s]; const float d0 = bf_lo(w.x), d1 = bf_hi(w.x), d2 = bf_lo(w.y), d3 = bf_hi(w.y), d4 = bf_lo(w.z), d5 = bf_hi(w.z), d6 = bf_lo(w.w), d7 = bf_hi(w.w);
                sum += ((d0 + d1) + (d2 + d3)) + ((d4 + d5) + (d6 + d7)); sq += ((d0 * d0 + d1 * d1) + (d2 * d2 + d3 * d3)) + ((d4 * d4 + d5 * d5) + (d6 * d6 + d7 * d7)); }
            asm volatile("" ::: "memory"); }
        sum += __shfl_xor(sum, 16); sum += __shfl_xor(sum, 32); sq += __shfl_xor(sq, 16); sq += __shfl_xor(sq, 32);
        const float mean = sum * (1.0f / D); const float rstd = 1.0f / sqrtf(fmaxf(sq * (1.0f / D) - mean * mean, 0.f) + LN_EPS);
        const float nmr = -mean * rstd;
        f32x4 acc0 = {0.f, 0.f, 0.f, 0.f}, acc1 = {0.f, 0.f, 0.f, 0.f};
        const LAS unsigned char* wrow = lds + (lane & 15) * 2048;
        const LAS float* gl = gcb + 8 * kg;
#pragma unroll
        for (int g = 0; g < 4; ++g) {
            if (g < 3) {
#pragma unroll
                for (int s = 0; s < 8; ++s) raw[(g + 1) & 1][s] = *(const v4u*)(Sp + 32 * (8 * (g + 1) + s)); }
#pragma unroll
            for (int s8 = 0; s8 < 8; ++s8) { const int s = 8 * g + s8; const v4u w = raw[g & 1][s8];
                const float xv[8] = {bf_lo(w.x), bf_hi(w.x), bf_lo(w.y), bf_hi(w.y), bf_lo(w.z), bf_hi(w.z), bf_lo(w.w), bf_hi(w.w)};
                float hh[8];
#pragma unroll
                for (int hq4 = 0; hq4 < 2; ++hq4) { const f32x4 g4 = *(const LAS f32x4*)(gl + 32 * s + 4 * hq4), b4 = *(const LAS f32x4*)(gl + 1024 + 32 * s + 4 * hq4);
#pragma unroll
                    for (int i = 0; i < 4; ++i) hh[4 * hq4 + i] = (xv[4 * hq4 + i] * rstd + nmr) * g4[i] + b4[i]; }
#if MOE_FP8
                { u32x2 o; o.x = pg8::pk4_fp8(hh[0] * FP8_ACT_S, hh[1] * FP8_ACT_S, hh[2] * FP8_ACT_S, hh[3] * FP8_ACT_S); o.y = pg8::pk4_fp8(hh[4] * FP8_ACT_S, hh[5] * FP8_ACT_S, hh[6] * FP8_ACT_S, hh[7] * FP8_ACT_S);
                  pg8::st8(Hp + 32 * s, o); }
#else
                { v4u o; o.x = pkbf(hh[0], hh[1]); o.y = pkbf(hh[2], hh[3]); o.z = pkbf(hh[4], hh[5]); o.w = pkbf(hh[6], hh[7]); *(v4u*)(Hp + 64 * s) = o; }
#endif
                v4u hi, lo;
                hi.x = pkbf(hh[0], hh[1]); hi.y = pkbf(hh[2], hh[3]); hi.z = pkbf(hh[4], hh[5]); hi.w = pkbf(hh[6], hh[7]);
                lo.x = pkbf(hh[0] - bf_lo(hi.x), hh[1] - bf_hi(hi.x)); lo.y = pkbf(hh[2] - bf_lo(hi.y), hh[3] - bf_hi(hi.y)); lo.z = pkbf(hh[4] - bf_lo(hi.z), hh[5] - bf_hi(hi.z)); lo.w = pkbf(hh[6] - bf_lo(hi.w), hh[7] - bf_hi(hi.w));
                const bf16x8 bhi = __builtin_bit_cast(bf16x8, hi), blo = __builtin_bit_cast(bf16x8, lo);
                const int swz = ((4 * s + kg) ^ (lane & 15)) << 4;
                const bf16x8 a0h = *(const LAS bf16x8*)(wrow + swz), a1h = *(const LAS bf16x8*)(wrow + 16 * 2048 + swz), a0l = *(const LAS bf16x8*)(wrow + 65536 + swz), a1l = *(const LAS bf16x8*)(wrow + 65536 + 16 * 2048 + swz);
                acc0 = __builtin_amdgcn_mfma_f32_16x16x32_bf16(a0h, bhi, acc0, 0, 0, 0); acc1 = __builtin_amdgcn_mfma_f32_16x16x32_bf16(a1h, bhi, acc1, 0, 0, 0);
                acc0 = __builtin_amdgcn_mfma_f32_16x16x32_bf16(a0l, bhi, acc0, 0, 0, 0); acc1 = __builtin_amdgcn_mfma_f32_16x16x32_bf16(a1l, bhi, acc1, 0, 0, 0);
                acc0 = __builtin_amdgcn_mfma_f32_16x16x32_bf16(a0h, blo, acc0, 0, 0, 0); acc1 = __builtin_amdgcn_mfma_f32_16x16x32_bf16(a1h, blo, acc1, 0, 0, 0);
                if (s8 & 1) asm volatile("" ::: "memory");
            }
        }
        float lg[8]; int le[8];
#pragma unroll
        for (int i = 0; i < 4; ++i) { le[i] = 4 * kg + i; le[4 + i] = 16 + 4 * kg + i; lg[i] = acc0[i] + rb[4 * kg + i]; lg[4 + i] = acc1[i] + rb[16 + 4 * kg + i]; }
        float tv[4]; int te[4];
#pragma unroll
        for (int k = 0; k < 4; ++k) {
            float bv = lg[0]; int be = le[0];
#pragma unroll
            for (int i = 1; i < 8; ++i) best2(bv, be, lg[i], le[i]);
            { const auto rv = __builtin_amdgcn_permlane16_swap(__float_as_uint(bv), __float_as_uint(bv), false, false); const auto re = __builtin_amdgcn_permlane16_swap((unsigned)be, (unsigned)be, false, false);
              bv = __uint_as_float(rv[0]); be = (int)re[0]; best2(bv, be, __uint_as_float(rv[1]), (int)re[1]); }
            { const auto rv = __builtin_amdgcn_permlane32_swap(__float_as_uint(bv), __float_as_uint(bv), false, false); const auto re = __builtin_amdgcn_permlane32_swap((unsigned)be, (unsigned)be, false, false);
              bv = __uint_as_float(rv[0]); be = (int)re[0]; best2(bv, be, __uint_as_float(rv[1]), (int)re[1]); }
            tv[k] = bv; te[k] = be;
#pragma unroll
            for (int i = 0; i < 8; ++i) lg[i] = (le[i] == be) ? -INFINITY : lg[i];
        }
        const float e1 = __expf(tv[1] - tv[0]), e2 = __expf(tv[2] - tv[0]), e3 = __expf(tv[3] - tv[0]), inv = 1.0f / (1.0f + e1 + e2 + e3);
        { const int e = kg == 0 ? te[0] : kg == 1 ? te[1] : kg == 2 ? te[2] : te[3]; const float gt = (kg == 0 ? 1.0f : kg == 1 ? e1 : kg == 2 ? e2 : e3) * inv;
          const unsigned lpos = atomicAdd((unsigned*)(hist + e), 1u);
          const int a = m * 4 + kg; tok_e[a] = e | (int)(lpos << 8); gates[a] = gt; }
    }
    __syncthreads();
    if (tid < 32) wg_hist[vcu * 32 + tid] = (int)hist[tid];
}
__device__ __forceinline__ void p_scatter(const bf16* H2, const int* tok_e, const float* gates, const int* wg_hist, bf16* xs, int* row_asg, float* row_gate, int* row_tok, int* meta,
                                          LAS unsigned char* lds, int vcu, int G, int tid, int wave, int lane) {
    LAS int* sm = (LAS int*)lds;
    { const int e = tid & 31, part = tid >> 5; int p = 0, s = 0;
      for (int w = part * 16; w < part * 16 + 16; ++w) { if (w < G) { const int h = wg_hist[w * 32 + e]; s += h; if (w < vcu) p += h; } }
      sm[part * 32 + e] = p; sm[512 + part * 32 + e] = s; }
    __syncthreads();
    if (tid < 32) { int p = 0, s = 0;
#pragma unroll
        for (int q = 0; q < 16; ++q) { p += sm[q * 32 + tid]; s += sm[512 + q * 32 + tid]; }
        sm[1024 + tid] = p; sm[1056 + tid] = s; }
    __syncthreads();
    if (tid == 0) { int us = 0; for (int e = 0; e < NE; ++e) { sm[1120 + e] = us; sm[1088 + e] = us * 256; us += (sm[1056 + e] + 255) >> 8; } sm[1120 + NE] = us; }
    __syncthreads();
    if (vcu == 0 && tid <= NE) meta[tid] = sm[1120 + tid];
    const int gw = vcu * NWAVES + wave, NGW = G * NWAVES;
    for (int e = vcu; e < NE; e += G) { const int r0 = sm[1088 + e] + sm[1056 + e], r1 = sm[1088 + e] + (((sm[1056 + e] + 255) >> 8) << 8);
#if MOE_FP8 && MOE_GATHER
        for (int r = r0 + wave; r < r1; r += NWAVES) { if (lane == 0) row_tok[r] = 0;
#elif MOE_FP8
        for (int r = r0 + wave; r < r1; r += NWAVES) { v4u z = {0u, 0u, 0u, 0u}; *(v4u*)((unsigned char*)xs + (size_t)r * D + 16 * lane) = z;
#else
        for (int r = r0 + wave; r < r1; r += NWAVES) { v4u z = {0u, 0u, 0u, 0u}; *(v4u*)(xs + (size_t)r * D + 8 * lane) = z; *(v4u*)(xs + (size_t)r * D + 512 + 8 * lane) = z;
#endif
            if (lane == 0) { row_asg[r] = -1; row_gate[r] = 0.f; } } }
#if MOE_FP8 && MOE_GATHER
#if ROUTER_MFMA
    for (int task = gw; task < T / 16; task += NGW) { const int a = task * 64 + lane;
        const int te = tok_e[a], e = te & 31, lpos = te >> 8; const int dest = sm[1088 + e] + sm[1024 + e] + lpos;
        row_asg[dest] = a; row_gate[dest] = gates[a]; row_tok[dest] = a >> 2; }
#else
    { const int grp = gw + (lane >> 4) * NGW;
      if (grp < T / 4) { const int a = grp * 16 + (lane & 15); const int te = tok_e[a], e = te & 31, lpos = te >> 8; const int dest = sm[1088 + e] + sm[1024 + e] + lpos;
          row_asg[dest] = a; row_gate[dest] = gates[a]; row_tok[dest] = a >> 2; } }
    static_assert(T / 4 == 4 * 256 * NWAVES, "one pass: 4 token groups per wave on the 256-workgroup grid");
#endif
}
#elif MOE_FP8
    typedef int v4i __attribute__((ext_vector_type(4)));
    v4u nrow[4]; v4i nte[4]; f32x4 ngt[4];
    if (gw < T / 4) {
#pragma unroll
        for (int tt = 0; tt < 4; ++tt) { const int m = gw * 4 + tt; nrow[tt] = *(const v4u*)((const unsigned char*)H2 + (size_t)m * D + 16 * lane); nte[tt] = *(const v4i*)(tok_e + m * 4); ngt[tt] = *(const f32x4*)(gates + m * 4); } }
    for (int grp = gw; grp < T / 4; grp += NGW) {
        v4u crow[4]; v4i cte[4]; f32x4 cgt[4];
#pragma unroll
        for (int tt = 0; tt < 4; ++tt) { crow[tt] = nrow[tt]; cte[tt] = nte[tt]; cgt[tt] = ngt[tt]; }
        if (grp + NGW < T / 4) {
#pragma unroll
            for (int tt = 0; tt < 4; ++tt) { const int m = (grp + NGW) * 4 + tt; nrow[tt] = *(const v4u*)((const unsigned char*)H2 + (size_t)m * D + 16 * lane); nte[tt] = *(const v4i*)(tok_e + m * 4); ngt[tt] = *(const f32x4*)(gates + m * 4); } }
#pragma unroll
        for (int tt = 0; tt < 4; ++tt) { const int m = grp * 4 + tt;
#pragma unroll
            for (int k = 0; k < 4; ++k) { const int te = cte[tt][k], e = te & 31, lpos = te >> 8; const int dest = sm[1088 + e] + sm[1024 + e] + lpos;
                *(v4u*)((unsigned char*)xs + (size_t)dest * D + 16 * lane) = crow[tt];
                if (lane == 0) { row_asg[dest] = m * 4 + k; row_gate[dest] = cgt[tt][k]; } } }
    }
}
#else
    for (int grp = gw; grp < T / 4; grp += NGW) {
#pragma unroll
        for (int tt = 0; tt < 4; ++tt) { const int m = grp * 4 + tt;
#if MOE_FP8
            const v4u r0 = *(const v4u*)((const unsigned char*)H2 + (size_t)m * D + 16 * lane);
#else
            const v4u r0 = *(const v4u*)(H2 + (size_t)m * D + 8 * lane), r1 = *(const v4u*)(H2 + (size_t)m * D + 512 + 8 * lane);
#endif
#pragma unroll
            for (int k = 0; k < 4; ++k) { const int te = tok_e[m * 4 + k], e = te & 31, lpos = te >> 8; const int dest = sm[1088 + e] + sm[1024 + e] + lpos;
#if MOE_FP8
                *(v4u*)((unsigned char*)xs + (size_t)dest * D + 16 * lane) = r0;
#else
                *(v4u*)(xs + (size_t)dest * D + 8 * lane) = r0; *(v4u*)(xs + (size_t)dest * D + 512 + 8 * lane) = r1;
#endif
                if (lane == 0) { row_asg[dest] = m * 4 + k; row_gate[dest] = gates[m * 4 + k]; } } }
    }
}
#endif
__device__ __forceinline__ int moe_table(const int* meta, LAS int* ru2e, int tid) {
    __syncthreads();
    if (tid < NE) { const int u0 = meta[tid], u1 = meta[tid + 1]; for (int u = u0; u < u1; ++u) ru2e[u] = tid; }
    const int nru = meta[NE];
    __syncthreads();
    return __builtin_amdgcn_readfirstlane(nru);
}
#if YK_FP8
typedef unsigned yk_t;
#define YK_LOAD(m, k, c) (*(const unsigned*)((const unsigned char*)yk + ((size_t)(m) * 4 + (k)) * D + (c)))
#else
typedef u32x2 yk_t;
#define YK_LOAD(m, k, c) (*(const u32x2*)(yk + ((size_t)(m) * 4 + (k)) * D + (c)))
#endif
template <int LAYER> __device__ __forceinline__ void p_final(bf16* X, const bf16* Sin, const float* lng0, const float* lnb0, const bf16* yk, const float* lng, const float* lnb, const float* modl, const float* modn, bf16* hq, unsigned char* x8, float* out,
                                                               int vcu, int G, int wave, int lane) {
    const int gw = vcu * NWAVES + wave, NGW = G * NWAVES, RPW = (T + NGW - 1) / NGW;
    const int m0 = gw * RPW, m1 = (m0 + RPW) < T ? (m0 + RPW) : T;
    if (m0 < m1) {
    yk_t ny[4][4]; u32x2 nxw[4];
#pragma unroll
    for (int j = 0; j < 4; ++j) { const int c = 256 * j + 4 * lane; nxw[j] = *(const u32x2*)((FINAL_FROM_S ? Sin : X) + (size_t)m0 * D + c);
#pragma unroll
        for (int k = 0; k < 4; ++k) ny[j][k] = YK_LOAD(m0, k, c); }
    f32x4 Lg0[4], Lb0[4], Lg[4], Lb[4], G2[4], SC[4], SH[4];
#pragma unroll
    for (int j = 0; j < 4; ++j) { const int c = 256 * j + 4 * lane; Lg0[j] = *(const f32x4*)(lng0 + c); Lb0[j] = *(const f32x4*)(lnb0 + c); Lg[j] = *(const f32x4*)(lng + c); Lb[j] = *(const f32x4*)(lnb + c); }
    int bcur = -1;
    for (int m = m0; m < m1; ++m) {
        const int b = m >> 11;
        if (b != bcur) { bcur = b; const float* g2 = modl + (size_t)b * 6144 + 5 * 1024; const float* sh = modn + (size_t)b * 6144;
#pragma unroll
            for (int j = 0; j < 4; ++j) { const int c = 256 * j + 4 * lane; G2[j] = *(const f32x4*)(g2 + c) + 1.0f;
                if (LAYER == 0) { SC[j] = *(const f32x4*)(sh + 1024 + c) + 1.0f; SH[j] = *(const f32x4*)(sh + c); } } }
        yk_t cy[4][4]; u32x2 cxw[4];
#pragma unroll
        for (int j = 0; j < 4; ++j) { cxw[j] = nxw[j];
#pragma unroll
            for (int k = 0; k < 4; ++k) cy[j][k] = ny[j][k]; }
        if (m + 1 < m1) {
#pragma unroll
            for (int j = 0; j < 4; ++j) { const int c = 256 * j + 4 * lane; nxw[j] = *(const u32x2*)((FINAL_FROM_S ? Sin : X) + (size_t)(m + 1) * D + c);
#pragma unroll
                for (int k = 0; k < 4; ++k) ny[j][k] = YK_LOAD(m + 1, k, c); } }
        f32x4 x1v[4];
#pragma unroll
        for (int j = 0; j < 4; ++j) { const u32x2 xw = cxw[j]; x1v[j] = (f32x4){bf_lo(xw.x), bf_hi(xw.x), bf_lo(xw.y), bf_hi(xw.y)}; }
#if FINAL_FROM_S
        { float s0 = 0.f;
#pragma unroll
          for (int j = 0; j < 4; ++j) s0 += (x1v[j][0] + x1v[j][1]) + (x1v[j][2] + x1v[j][3]);
          const float mean0 = wave_sum(s0) * (1.0f / D); float q0 = 0.f;
#pragma unroll
          for (int j = 0; j < 4; ++j) { x1v[j] = x1v[j] - mean0; q0 += (x1v[j][0] * x1v[j][0] + x1v[j][1] * x1v[j][1]) + (x1v[j][2] * x1v[j][2] + x1v[j][3] * x1v[j][3]); }
          const float rstd0 = 1.0f / sqrtf(wave_sum(q0) * (1.0f / D) + LN_EPS);
#pragma unroll
          for (int j = 0; j < 4; ++j) x1v[j] = x1v[j] * rstd0 * Lg0[j] + Lb0[j]; }
#endif
        f32x4 v[4]; float s = 0.f;
#pragma unroll
        for (int j = 0; j < 4; ++j) {
            f32x4 y = {0.f, 0.f, 0.f, 0.f};
#pragma unroll
            for (int k = 0; k < 4; ++k) {
#if YK_FP8
                const unsigned w = cy[j][k]; const f32x2_t p0 = __builtin_amdgcn_cvt_pk_f32_fp8((int)w, false), p1 = __builtin_amdgcn_cvt_pk_f32_fp8((int)w, true); y[0] += p0.x; y[1] += p0.y; y[2] += p1.x; y[3] += p1.y;
#else
                const u32x2 w = cy[j][k]; y[0] += bf_lo(w.x); y[1] += bf_hi(w.x); y[2] += bf_lo(w.y); y[3] += bf_hi(w.y);
#endif
            }
#if YK_FP8
            y = y * (1.0f / pg8::YK_S);
#endif
            v[j] = x1v[j] * ALPHA_DN + G2[j] * y;
            s += (v[j][0] + v[j][1]) + (v[j][2] + v[j][3]); }
        const float mean = wave_sum(s) * (1.0f / D); float q = 0.f;
#pragma unroll
        for (int j = 0; j < 4; ++j) { v[j] = v[j] - mean; q += (v[j][0] * v[j][0] + v[j][1] * v[j][1]) + (v[j][2] * v[j][2] + v[j][3] * v[j][3]); }
        const float rstd = 1.0f / sqrtf(wave_sum(q) * (1.0f / D) + LN_EPS);
#pragma unroll
        for (int j = 0; j < 4; ++j) { const int c = 256 * j + 4 * lane;
            const f32x4 x2 = v[j] * rstd * Lg[j] + Lb[j];
            if (LAYER == 0) {
                u32x2 w; w.x = pkbf(x2[0], x2[1]); w.y = pkbf(x2[2], x2[3]); pg8::st8(X + (size_t)m * D + c, w);
                const f32x4 h = x2 * SC[j] + SH[j];
#if DENSE8_QKV
                pg8::st4(x8 + (size_t)m * D + c, pg8::pk4_fp8(x2[0] * DENSE8_A_S, x2[1] * DENSE8_A_S, x2[2] * DENSE8_A_S, x2[3] * DENSE8_A_S));
                pg8::st4((unsigned char*)hq + (size_t)m * D + c, pg8::pk4_fp8(h[0] * DENSE8_A_S, h[1] * DENSE8_A_S, h[2] * DENSE8_A_S, h[3] * DENSE8_A_S));
#else
                u32x2 w2; w2.x = pkbf(h[0], h[1]); w2.y = pkbf(h[2], h[3]); pg8::st8(hq + (size_t)m * D + c, w2);
#endif
            } else pg8::st16_plain(out + (size_t)m * D + c, __builtin_bit_cast(pg8::u32x4, x2));
        }
    }
    }
}
__device__ __forceinline__ int crow(int r, int hi) { return (r & 3) + 8 * (r >> 2) + 4 * hi; }
#define MFMA32(a, b, c) __builtin_amdgcn_mfma_f32_32x32x16_bf16((a), (b), (c), 0, 0, 0)
__device__ __forceinline__ bf16x8 pack8(const f32x16& x, int s) {
    v4u p; p.x = pkbf(x[8 * s], x[8 * s + 1]); p.y = pkbf(x[8 * s + 2], x[8 * s + 3]); p.z = pkbf(x[8 * s + 4], x[8 * s + 5]); p.w = pkbf(x[8 * s + 6], x[8 * s + 7]);
    return __builtin_bit_cast(bf16x8, p);
}
template <bool DIAG, bool SKIPHI = false, bool MASKLO = DIAG> __device__ __forceinline__ void attn_tile(const LAS unsigned char* Ks, const LAS unsigned char* Vs, const bf16x8 (&qr)[4], const bf16x8& ones, const bf16x8& Ua, const bf16x8& Ub,
                                                                f32x16 (&o)[2], float& R, int kv0, int qpos, int r, int h) {
    constexpr int KP = 144, VP = 136;
    const f32x16 zero = {};
    bf16x8 pa[4];
    f32x16 T1;
    if constexpr (SKIPHI) { T1 = zero; pa[2] = bf16x8{}; pa[3] = bf16x8{}; }
    else
    { f32x16 p1 = zero;
#pragma unroll
      for (int s = 0; s < 4; ++s) { const bf16x8 k1 = *(const LAS bf16x8*)(Ks + (32 + r) * KP + (16 * s + 8 * h) * 2); p1 = MFMA32(k1, qr[s], p1); }
      f32x16 L1;
#pragma unroll
      for (int i = 0; i < 16; ++i) { const float z = p1[i]; float L = -__builtin_amdgcn_logf(1.0f + __builtin_amdgcn_exp2f(__builtin_amdgcn_fmed3f(z, -1.0e30f, 100.0f)));
          if (DIAG) L = (kv0 + 32 + crow(i, h) < qpos) ? L : 0.f; L1[i] = L; p1[i] = (z + R) + L; }
      const bf16x8 l1a = pack8(L1, 0), l1b = pack8(L1, 1);
      T1 = MFMA32(ones, l1a, zero); T1 = MFMA32(ones, l1b, T1);
      f32x16 S1 = MFMA32(Ua, l1a, zero); S1 = MFMA32(Ub, l1b, S1);
#pragma unroll
      for (int i = 0; i < 16; ++i) { float a1 = __builtin_amdgcn_exp2f(p1[i] + S1[i]); if (DIAG) a1 = (kv0 + 32 + crow(i, h) < qpos) ? a1 : 0.f; p1[i] = a1; }
      pa[2] = pack8(p1, 0); pa[3] = pack8(p1, 1); }
    __builtin_amdgcn_sched_barrier(0);
    bool lo_dead = false;
#if ATT_MIDEXIT
    if constexpr (!DIAG) lo_dead = __all(R + T1[0] < -150.0f) != 0;
#endif
    if (lo_dead) { R += T1[0]; }
    else
    { f32x16 p0 = zero;
#pragma unroll
      for (int s = 0; s < 4; ++s) { const bf16x8 k0 = *(const LAS bf16x8*)(Ks + r * KP + (16 * s + 8 * h) * 2); p0 = MFMA32(k0, qr[s], p0); }
      f32x16 L0;
#pragma unroll
      for (int i = 0; i < 16; ++i) { const float z = p0[i]; float L = -__builtin_amdgcn_logf(1.0f + __builtin_amdgcn_exp2f(__builtin_amdgcn_fmed3f(z, -1.0e30f, 100.0f)));
          if (MASKLO) L = (kv0 + crow(i, h) < qpos) ? L : 0.f; L0[i] = L; p0[i] = (z + R) + L; }
      const bf16x8 l0a = pack8(L0, 0), l0b = pack8(L0, 1);
      f32x16 S0 = MFMA32(Ua, l0a, T1); S0 = MFMA32(Ub, l0b, S0);
      { f32x16 Rn = MFMA32(ones, l0a, T1); Rn = MFMA32(ones, l0b, Rn); R += Rn[0]; }
#pragma unroll
      for (int i = 0; i < 16; ++i) { float a0 = __builtin_amdgcn_exp2f(p0[i] + S0[i]); if (MASKLO) a0 = (kv0 + crow(i, h) < qpos) ? a0 : 0.f; p0[i] = a0; }
      pa[0] = pack8(p0, 0); pa[1] = pack8(p0, 1); }
    __builtin_amdgcn_sched_barrier(0);
#pragma unroll
    for (int dh = 0; dh < 2; ++dh)
#pragma unroll
        for (int hf = 0; hf < 2; ++hf)
#pragma unroll
            for (int c = 0; c < 2; ++c) { if (SKIPHI && hf == 1) continue;
                if (lo_dead && hf == 0) continue;
                const LAS unsigned char* ap = Vs + (32 * dh + r) * VP + (32 * hf + 16 * c + 4 * h) * 2;
                const s16x4 lo = *(const LAS s16x4*)ap, hi = *(const LAS s16x4*)(ap + 16);
                const bf16x8 vf = __builtin_shufflevector(lo, hi, 0, 1, 2, 3, 4, 5, 6, 7);
                o[dh] = MFMA32(pa[2 * hf + c], vf, o[dh]); }
}
#ifndef ATT_WIDE_STORE
#define ATT_WIDE_STORE 1
#endif
#ifndef ATT_MIDEXIT
#define ATT_MIDEXIT 1
#endif
#ifndef ATT_QPREF
#define ATT_QPREF 0
#endif
constexpr int ATT_WIN = 7, ATT_TILE_B = 64 * 144 + 64 * 136;
static_assert(ATT_WIN * ATT_TILE_B <= RING_BYTES, "attention window fits the ring region");
__device__ __forceinline__ void attn_stage7(const bf16* kb, const bf16* vb, LAS unsigned char* lds, int lo, int hi, int srow, int sch) {
    constexpr int KP = 144, VP = 136;
    v4u kreg[ATT_WIN], vreg[ATT_WIN];
#pragma unroll
    for (int i = 0; i < ATT_WIN; ++i) { const int t = (lo + i) < hi ? (lo + i) : hi; kreg[i] = *(const v4u*)(kb + (size_t)t * 64 * D); vreg[i] = *(const v4u*)(vb + t * 64); }
#pragma unroll
    for (int i = 0; i < ATT_WIN; ++i) { const int t = (lo + i) < hi ? (lo + i) : hi; LAS unsigned char* sl = lds + (t % ATT_WIN) * ATT_TILE_B;
        *(LAS v4u*)(sl + srow * KP + sch * 16) = kreg[i];
        { u32x2 a2 = {vreg[i].x, vreg[i].y}, c2 = {vreg[i].z, vreg[i].w}; *(LAS u32x2*)(sl + 64 * KP + srow * VP + sch * 16) = a2; *(LAS u32x2*)(sl + 64 * KP + srow * VP + sch * 16 + 8) = c2; } }
}
__device__ __forceinline__ void p_attn(const bf16* Q, const bf16* K, const bf16* VT, bf16* O, LAS unsigned char* lds, LAS unsigned* donecnt, int vcu, int G, int tid, int wave, int lane) {
    constexpr int KP = 144, VP = 136;
    const int r = lane & 31, h = lane >> 5;
    bf16x8 ones, Ua, Ub;
#pragma unroll
    for (int j = 0; j < 8; ++j) { ones[j] = (short)0x3F80; const int ka = 8 * (j >> 2) + 4 * h + (j & 3), kb = 16 + ka; Ua[j] = (ka > r) ? (short)0x3F80 : (short)0; Ub[j] = (kb > r) ? (short)0x3F80 : (short)0; }
    const int srow = tid >> 3, sch = tid & 7;
    for (int bh = vcu; bh < NBATCH * NHEAD; bh += G) {
        const int b = bh >> 4, hh = bh & 15; const size_t rowbase = (size_t)b * SEQ;
        const bf16* kb = K + (rowbase + srow) * D + hh * HDIM + 8 * sch; const bf16* vb = VT + (size_t)(hh * HDIM + srow) * T + rowbase + 8 * sch;
        __syncthreads();
        attn_stage7(kb, vb, lds, 0, 3, srow, sch);
#if ATT_QPREF
        bf16x8 qn[4];
#endif
        for (int qb = 0; qb < SEQ / 256; ++qb) {
            const int q0 = qb * 256, qw = q0 + 32 * (wave < 4 ? wave : (wave ^ 1));
            const bf16* qp = Q + (rowbase + qw + r) * D + hh * HDIM + 8 * h;
            bf16x8 qr[4];
#if ATT_QPREF
            if (qb == 0) {
#pragma unroll
                for (int s = 0; s < 4; ++s) qr[s] = *(const bf16x8*)(qp + 16 * s); }
            else {
#pragma unroll
                for (int s = 0; s < 4; ++s) qr[s] = qn[s]; }
#else
#pragma unroll
            for (int s = 0; s < 4; ++s) qr[s] = *(const bf16x8*)(qp + 16 * s);
#endif
            f32x16 o[2]; o[0] = f32x16{}; o[1] = f32x16{}; float Rv = 0.f;
            int jt = (qw + 30) >> 6;
            bool done = false, marked = false, clobbered = false;
            v4u pk[4], pv[4]; const bool has_next = qb + 1 < SEQ / 256;
            if (has_next) {
#pragma unroll
                for (int i = 0; i < 4; ++i) { const int t = 4 * qb + 4 + i; pk[i] = *(const v4u*)(kb + (size_t)t * 64 * D); pv[i] = *(const v4u*)(vb + t * 64); }
#if ATT_QPREF
#pragma unroll
                for (int s = 0; s < 4; ++s) qn[s] = *(const bf16x8*)(qp + (size_t)256 * D + 16 * s);
#endif
            }
            LAS unsigned* dc = donecnt + (qb & 1);
            for (int win_hi = 4 * qb + 3; ; ) {
                const int win_lo = (win_hi - (ATT_WIN - 1)) > 0 ? (win_hi - (ATT_WIN - 1)) : 0;
                __syncthreads();
                if (tid == 0) donecnt[(qb & 1) ^ 1] = 0u;
                for (; jt >= win_lo && !done; --jt) {
                    const LAS unsigned char* Ks = lds + (jt % ATT_WIN) * ATT_TILE_B; const LAS unsigned char* Vs = Ks + 64 * KP;
                    const int kv0 = 64 * jt;
                    if (kv0 >= qw) attn_tile<true, true>(Ks, Vs, qr, ones, Ua, Ub, o, Rv, kv0, qw + r, r, h);
                    else if (kv0 + 63 >= qw) attn_tile<true, false, false>(Ks, Vs, qr, ones, Ua, Ub, o, Rv, kv0, qw + r, r, h);
                    else attn_tile<false>(Ks, Vs, qr, ones, Ua, Ub, o, Rv, kv0, qw + r, r, h);
                    done = __all(Rv < -150.0f) != 0;
                }
                if (jt < 0) done = true;
                if (done && !marked) { marked = true; if (lane == 0) atomicAdd((unsigned*)dc, 1u); }
                __syncthreads();
                if (*dc == (unsigned)NWAVES) break;
                win_hi = win_lo - 1; clobbered = true;
                attn_stage7(kb, vb, lds, (win_hi - (ATT_WIN - 1)) > 0 ? (win_hi - (ATT_WIN - 1)) : 0, win_hi, srow, sch);
            }
#if DENSE8_P12 && ATT_WIDE_STORE
            { const int jq = lane & 3; const unsigned sel1 = (jq & 1) ? 0x03070105u : 0x06020400u, sel2 = (jq & 2) ? 0x03020706u : 0x05040100u;
              unsigned char* ob = (unsigned char*)O + (rowbase + qw + jq + 4 * h) * D + hh * HDIM + 4 * (r >> 2);
#pragma unroll
              for (int dh = 0; dh < 2; ++dh)
#pragma unroll
                for (int g = 0; g < 4; ++g) {
                    const unsigned P = pg8::pk4_fp8(o[dh][4 * g] * DENSE8_A_S, o[dh][4 * g + 1] * DENSE8_A_S, o[dh][4 * g + 2] * DENSE8_A_S, o[dh][4 * g + 3] * DENSE8_A_S);
                    const unsigned X = (unsigned)dppi<0xB1>((int)P), A = __builtin_amdgcn_perm(X, P, sel1);
                    const unsigned Y = (unsigned)dppi<0x4E>((int)A), Q = __builtin_amdgcn_perm(Y, A, sel2);
                    pg8::st4(ob + (size_t)(8 * g) * D + 32 * dh, Q); } }
#else
#pragma unroll
            for (int dh = 0; dh < 2; ++dh)
#pragma unroll
                for (int i = 0; i < 16; ++i) {
#if DENSE8_P12
                    const float ov = pg8::clamp448(o[dh][i] * DENSE8_A_S); const unsigned w8 = __builtin_amdgcn_cvt_pk_fp8_f32(ov, ov, 0u, false);
                    pg8::st1((unsigned char*)O + (rowbase + qw + crow(i, h)) * D + hh * HDIM + 32 * dh + r, (unsigned char)w8); }
#else
                    const unsigned w = pkbf(o[dh][i], 0.f); O[(rowbase + qw + crow(i, h)) * D + hh * HDIM + 32 * dh + r] = (bf16)(w & 0xffffu); }
#endif
#endif
            if (has_next) {
                if (!clobbered) {
#pragma unroll
                    for (int i = 0; i < 4; ++i) { const int t = 4 * qb + 4 + i; LAS unsigned char* sl = lds + (t % ATT_WIN) * ATT_TILE_B;
                        *(LAS v4u*)(sl + srow * KP + sch * 16) = pk[i];
                        { u32x2 a2 = {pv[i].x, pv[i].y}, c2 = {pv[i].z, pv[i].w}; *(LAS u32x2*)(sl + 64 * KP + srow * VP + sch * 16) = a2; *(LAS u32x2*)(sl + 64 * KP + srow * VP + sch * 16 + 8) = c2; } }
                } else attn_stage7(kb, vb, lds, 4 * qb + 1, 4 * qb + 7, srow, sch);
            }
        }
    }
}

#ifndef MOE_ALIGN
#define MOE_ALIGN true
#endif
#ifndef MK_PER_PHASE
#define MK_PER_PHASE 0
#endif
constexpr int N_PHASES = 18;
struct Args { const float* in[23]; float* out; unsigned char* ws; int ph_lo, ph_hi; };
static_assert(sizeof(Args) == 23 * 8 + 8 + 8 + 8, "Args has no padding bytes");

__global__ void __launch_bounds__(NTHREADS, 2) yoco_fwd(Args args) {
    extern __shared__ __attribute__((aligned(16))) unsigned char lds_raw[];
    LAS unsigned char* lds = (LAS unsigned char*)lds_raw;
    const int G = gridDim.x; const int bx = blockIdx.x; const int vcu = (G % 8 == 0) ? (bx % 8) * (G / 8) + bx / 8 : bx;
    gu32* ctl = (gu32*)(args.ws + WS_CTL);
    for (int u = threadIdx.x; u < (LDS_BYTES - LDSCTL_OFF) / 4; u += NTHREADS) ((LAS unsigned*)(lds + LDSCTL_OFF))[u] = 0u;
    __syncthreads();
    XcdBarrier bar; bar.bar = (unsigned*)(ctl + CW_BAR); bar.x = 0; bar.st = nullptr;
    if (!MK_PER_PHASE) bar = xcd_barrier_post((unsigned*)(ctl + CW_BAR), (volatile LAS unsigned*)(lds + LDSCTL_OFF));
    LAS unsigned* hist = (LAS unsigned*)(lds + LDSCTL_OFF + 64);
    LAS int* ru2e = (LAS int*)(lds + LDSCTL_OFF + 256);
    const int lo = args.ph_lo, hi = args.ph_hi;
#define LAUNDER() int tid = threadIdx.x; asm volatile("" : "+v"(tid)); const int lane = tid & 63, wave = __builtin_amdgcn_readfirstlane(tid >> 6); (void)lane; (void)wave
#ifndef PHASE_MASK
#define PHASE_MASK 0x3ffff
#endif
#define IN(k) ((((PHASE_MASK) >> (k)) & 1) && lo <= (k) && (k) < hi)
#ifndef REPEAT_MASK
#define REPEAT_MASK 0
#endif
#define REPEAT(kc) _Pragma("unroll") for (int rep_ = 0; rep_ < 1 + (((REPEAT_MASK) >> (kc)) & 1); (__syncthreads(), ++rep_))
#define REPEAT_L1(kc) _Pragma("unroll") for (int rep_ = 0; rep_ < 1 + ((((REPEAT_MASK) >> (kc)) & 1) && l == 1); (__syncthreads(), ++rep_))
#if defined(PROBE_DOUBLE_BARRIER)
#define SEAM(k) do { if (IN(k) && IN((k) + 1)) { int nb_ = 2; asm volatile("" : "+s"(nb_)); for (int r_ = 0; r_ < nb_; ++r_) xcd_barrier(bar); } } while (0)
#else
#define SEAM(k) do { if (IN(k) && IN((k) + 1)) xcd_barrier(bar); } while (0)
#endif

#define KIN(i) ((const float*)karg(8u * (unsigned)(i)))
#define WSP(type, off) ((type*)((unsigned char*)karg(192u) + (off)))
#define xin KIN(0)
#define cin KIN(1)
#define ada_w KIN(2)
#define ada_b KIN(3)
#define ln_g KIN(4)
#define ln_b KIN(5)
#define cv_b1 KIN(7)
#define cv_dw KIN(8)
#define cv_db KIN(9)
#define cv_lg KIN(10)
#define cv_lb KIN(11)
#define cv_b2 KIN(13)
#define router_w KIN(17)
#define router_b KIN(18)
#define moe_b_in KIN(20)
#define moe_b_out KIN(22)
#define mod WSP(float, WS_MOD)
#define wg_hist WSP(int, WS_HIST)
#define meta WSP(int, WS_META)
#define tok_e WSP(int, WS_TOKE)
#define gates WSP(float, WS_GATE)
#define row_asg WSP(int, WS_RASG)
#define row_gate WSP(float, WS_RGATE)
#define row_tok WSP(int, WS_RTOK)
#define rwt WSP(bf16, WS_RWT)
#define w1t WSP(bf16, WS_W1T)
#define w2t WSP(bf16, WS_W2T)
#define kvt WSP(bf16, WS_KVT)
#define qt WSP(bf16, WS_QT)
#define ot WSP(bf16, WS_OT)
#define mint WSP(bf16, WS_MIN)
#define moutt WSP(bf16, WS_MOUT)
#define xs WSP(bf16, WS_RA)
#define yk WSP(bf16, WS_RA)
#define act WSP(bf16, WS_RB)
#define hA WSP(bf16, WS_RB)
#define glu WSP(bf16, WS_RB + 64 * MiB)
#define u2 WSP(bf16, WS_RB + 128 * MiB)
#define Qb WSP(bf16, WS_RB)
#define Kb WSP(bf16, WS_RB + 64 * MiB)
#define VTb WSP(bf16, WS_RB + 128 * MiB)
#define Ob WSP(bf16, WS_RB + 192 * MiB)
#define Sb WSP(bf16, WS_S)
#define Xb WSP(bf16, WS_X)
#define H2 WSP(bf16, WS_H2)
#define x2b WSP(bf16, WS_X2B)
#define hq WSP(bf16, WS_HQ)
#define d_outp ((float*)karg(184u))

#ifndef P01_FUSED
#define P01_FUSED 1
#endif
    if (IN(0)) REPEAT(0) { LAUNDER();
        p_ada(cin, ada_w, ada_b, mod, lds, vcu, G, tid, wave, lane);
#if P01_FUSED
        asm volatile("s_waitcnt vmcnt(0)" ::: "memory"); __syncthreads();
        if (tid == 0) { __builtin_amdgcn_fence(__ATOMIC_RELEASE, "agent"); asm volatile("s_waitcnt vmcnt(0)" ::: "memory");
            __hip_atomic_fetch_add((unsigned*)(ctl + CW_ADA), 1u, __ATOMIC_RELAXED, __HIP_MEMORY_SCOPE_AGENT); }
#endif
        WPtrs P{KIN(6), KIN(12), KIN(14), KIN(15), KIN(16), KIN(19), KIN(21), w1t, w2t, kvt, qt, ot, mint, moutt};
        p_convert(P, lds, vcu, G, tid);
#if ROUTER_MFMA
        p_rwt(router_w, rwt, vcu, G, tid);
#endif
    }
#if !P01_FUSED
    SEAM(0);
#endif
    if (IN(1)) REPEAT(1) { LAUNDER();
#if P01_FUSED
        if (IN(0)) {
            if (tid == 0) { unsigned sp = 0; while (__hip_atomic_load((unsigned*)(ctl + CW_ADA), __ATOMIC_RELAXED, __HIP_MEMORY_SCOPE_AGENT) < (unsigned)G) { __builtin_amdgcn_s_sleep(2); if (++sp > (1u << 22)) break; }
                __builtin_amdgcn_fence(__ATOMIC_ACQUIRE, "agent"); asm volatile("s_waitcnt vmcnt(0)" ::: "memory"); }
            __syncthreads(); }
#endif
        p_modulate(xin, mod, hA, vcu, G, wave, lane); }
    SEAM(1);
    if (IN(2)) REPEAT(2) { pg8::Gemm g{hA, w1t, DENSE8_P2 ? 512 : 1024, 0}; pg8::StaticOrder S; S.init(T, 2048, G, bx); pg8::EpiGlu<0> E{glu, cv_b1, DENSE8_P2 ? 1.0f / (DENSE8_W_S * DENSE8_A_S) : 1.0f, 1.0f, nullptr};
        pg8::gemm_phase<pg8::EpiGlu<0>, pg8::StaticOrder, true, true, DENSE8_P2 != 0>(lds + RING_OFF, g, S, E); }
    SEAM(2);
    if (IN(3)) REPEAT(3) { LAUNDER(); WPtrs P{KIN(6), KIN(12), KIN(14), KIN(15), KIN(16), KIN(19), KIN(21), w1t, w2t, kvt, qt, ot, mint, moutt};
        p_conv(glu, cv_dw, cv_db, cv_lg, cv_lb, u2, lds, vcu, G, tid, wave, lane, P); }
    SEAM(3);
    if (IN(4)) REPEAT(4) { pg8::Gemm g{u2, w2t, DENSE8_P4 ? 512 : 1024, 0}; pg8::StaticOrder S; S.init(T, 1024, G, bx); pg8::EpiResid<false> E{xin, Sb, cv_b2, mod + 2 * 1024, DENSE8_P4 ? 1.0f / (DENSE8_W_S * DENSE8_A_S) : 1.0f};
        pg8::gemm_phase<pg8::EpiResid<false>, pg8::StaticOrder, true, true, DENSE8_P4 != 0>(lds + RING_OFF, g, S, E); }
    SEAM(4);
#pragma unroll 1
    for (int l = 0; l < 2; ++l) {
        const int pb = l == 0 ? 5 : 13;
        const size_t modoff = (size_t)l * 16 * 6144;
        if (l == 1) {
            if (IN(10)) REPEAT(10) {
#if DENSE8_QKV
                constexpr float qkv_s = 1.0f / (DENSE8_W_S * DENSE8_A_S);
                { pg8::Gemm g{x2b, kvt, 512, 0}; pg8::StaticOrder S; S.init(T, 1024, G, bx); pg8::EpiBf16 E{Kb, 1024, qkv_s};
                  pg8::gemm_phase<pg8::EpiBf16, pg8::StaticOrder, true, true, true>(lds + RING_OFF, g, S, E); }
                { pg8::Gemm g{(const bf16*)((const unsigned char*)kvt + (size_t)1024 * 1024), x2b, 512, 0}; pg8::StaticOrder S; S.init(1024, T, G, bx); pg8::EpiBf16 E{VTb, T, qkv_s};
                  pg8::gemm_phase<pg8::EpiBf16, pg8::StaticOrder, true, true, true>(lds + RING_OFF, g, S, E); }
                { pg8::Gemm g{hq, qt, 512, 0}; pg8::StaticOrder S; S.init(T, 1024, G, bx); pg8::EpiBf16 E{Qb, 1024, 0.125f * LOG2E * qkv_s};
                  pg8::gemm_phase<pg8::EpiBf16, pg8::StaticOrder, true, true, true>(lds + RING_OFF, g, S, E); }
#else
                { pg8::Gemm g{Xb, kvt, 1024, 0}; pg8::StaticOrder S; S.init(T, 1024, G, bx); pg8::EpiBf16 E{Kb, 1024, 1.0f};
                  pg8::gemm_phase<pg8::EpiBf16, pg8::StaticOrder, true, true>(lds + RING_OFF, g, S, E); }
                { pg8::Gemm g{kvt + (size_t)1024 * 1024, Xb, 1024, 0}; pg8::StaticOrder S; S.init(1024, T, G, bx); pg8::EpiBf16 E{VTb, T, 1.0f};
                  pg8::gemm_phase<pg8::EpiBf16, pg8::StaticOrder, true, true>(lds + RING_OFF, g, S, E); }
                { pg8::Gemm g{hq, qt, 1024, 0}; pg8::StaticOrder S; S.init(T, 1024, G, bx); pg8::EpiBf16 E{Qb, 1024, 0.125f * LOG2E};
                  pg8::gemm_phase<pg8::EpiBf16, pg8::StaticOrder, true, true>(lds + RING_OFF, g, S, E); }
#endif
            }
            SEAM(10);
            if (IN(11)) REPEAT(11) { LAUNDER(); p_attn(Qb, Kb, VTb, Ob, lds, (LAS unsigned*)(lds + LDSCTL_OFF + 32), vcu, G, tid, wave, lane); }
            SEAM(11);
            if (IN(12)) REPEAT(12) { pg8::Gemm g{Ob, ot, DENSE8_P12 ? 512 : 1024, 0}; pg8::StaticOrder S; S.init(T, 1024, G, bx); pg8::EpiResid<true> E{Xb, Sb, nullptr, mod + modoff + 2 * 1024, DENSE8_P12 ? 1.0f / (DENSE8_W_S * DENSE8_A_S) : 1.0f};
                pg8::gemm_phase<pg8::EpiResid<true>, pg8::StaticOrder, true, true, DENSE8_P12 != 0>(lds + RING_OFF, g, S, E); }
            SEAM(12);
        }
#if ROUTER_MFMA
        if (IN(pb)) REPEAT(5) { LAUNDER(); p_router_mfma(Sb, ln_g + (size_t)(l * 2) * D, ln_b + (size_t)(l * 2) * D, mod + modoff, rwt + (size_t)l * 2 * NE * D, router_b + l * NE, Xb, H2, tok_e, gates, wg_hist, lds, hist, vcu, G, tid, wave, lane); }
#else
        if (IN(pb)) REPEAT(5) { LAUNDER(); p_router(Sb, ln_g + (size_t)(l * 2) * D, ln_b + (size_t)(l * 2) * D, mod + modoff, router_w + (size_t)l * D * NE, router_b + l * NE, Xb, H2, tok_e, gates, wg_hist, lds, hist, vcu, G, tid, wave, lane); }
#endif
        SEAM(pb);
        if (IN(pb + 1)) REPEAT(6) { LAUNDER(); p_scatter(H2, tok_e, gates, wg_hist, xs, row_asg, row_gate, row_tok, meta, lds, vcu, G, tid, wave, lane); }
        SEAM(pb + 1);
        if (IN(pb + 2)) REPEAT(7) { LAUNDER(); const int nru = moe_table(meta, ru2e, tid);
#if MOE_FP8
            pg8::MoeOrderT<MOE_HANDOFF ? 1 : 0> S; S.init(nru, 8, G, bx, ru2e, (LAS int*)(lds + LDSCTL_OFF + 3072)); S.cnt = (unsigned*)(ctl + CW_CNT + l * CNT_LAYER_WORDS); S.build(tid); __syncthreads();
            pg8::EpiGlu<2> E{act, moe_b_in + (size_t)l * NE * 2048, 1.0f / (FP8_WIN_S * FP8_ACT_S), FP8_ACT_S, (LAS float*)(lds + LDSCTL_OFF + 8192)};
#if MOE_GATHER
            pg8::Gemm g{H2, (const bf16*)((const unsigned char*)mint + (size_t)l * NE * 2048 * 1024), 512, (size_t)2048 * 1024, row_tok, (LAS int*)(lds + LDSCTL_OFF + 4096)};
            pg8::gemm_phase<pg8::EpiGlu<2>, pg8::MoeOrderT<MOE_HANDOFF ? 1 : 0>, MOE_ALIGN, true, true, true>(lds + RING_OFF, g, S, E);
            if (MOE_HANDOFF && tid == 0) (void)__hip_atomic_fetch_add((unsigned*)(ctl + CW_CNT + l * CNT_LAYER_WORDS + pg8::MoeOrderT<2>::ALLW), 1u, __ATOMIC_RELAXED, __HIP_MEMORY_SCOPE_AGENT); }
#else
            pg8::Gemm g{xs, (const bf16*)((const unsigned char*)mint + (size_t)l * NE * 2048 * 1024), 512, (size_t)2048 * 1024};
            pg8::gemm_phase<pg8::EpiGlu<2>, pg8::MoeOrder, MOE_ALIGN, true, true>(lds + RING_OFF, g, S, E); }
#endif
#else
            pg8::Gemm g{xs, mint + (size_t)l * NE * 2048 * 1024, 1024, (size_t)2048 * 1024 * 2}; pg8::MoeOrder S; S.init(nru, 8, G, bx, ru2e, (LAS int*)(lds + LDSCTL_OFF + 3072)); S.build(tid); __syncthreads();
            pg8::EpiGlu<1> E{act, moe_b_in + (size_t)l * NE * 2048, 1.0f, 1.0f, nullptr};
            pg8::gemm_phase<pg8::EpiGlu<1>, pg8::MoeOrder, true, true>(lds + RING_OFF, g, S, E); }
#endif
#if !(MOE_HANDOFF && MOE_FP8 && MOE_GATHER)
        SEAM(pb + 2);
#endif
        if (IN(pb + 3)) REPEAT(8) { LAUNDER(); const int nru = moe_table(meta, ru2e, tid);
#if MOE_FP8
            pg8::Gemm g{act, (const bf16*)((const unsigned char*)moutt + (size_t)l * NE * 1024 * 1024), 512, (size_t)1024 * 1024}; pg8::MoeOrderT<MOE_HANDOFF ? 2 : 0> S;
            int c2 = bx; if (MOE_HANDOFF && (G % 8) == 0) { const int W = G / 8, rk = bx / 8, sh = nru % W; const int rk2 = rk - sh < 0 ? rk - sh + W : rk - sh; c2 = rk2 * 8 + (bx % 8); }
            S.init(nru, 4, G, c2, ru2e, (LAS int*)(lds + LDSCTL_OFF + 3072)); S.cnt = (unsigned*)(ctl + CW_CNT + l * CNT_LAYER_WORDS); S.need = 64u; S.rot = 2 * MOE_WGM * 4;
            S.allflag = (LAS unsigned*)(lds + LDSCTL_OFF + 48); S.allneed = (unsigned)G; if (tid == 0) *S.allflag = 0xffffffffu; S.build(tid); __syncthreads();
            pg8::EpiMoeOut E{yk, moe_b_out + (size_t)l * NE * 1024, row_asg, row_gate, 1.0f / (FP8_WOUT_S * FP8_ACT_S), (LAS float*)(lds + LDSCTL_OFF + 8192)};
            pg8::gemm_phase<pg8::EpiMoeOut, pg8::MoeOrderT<MOE_HANDOFF ? 2 : 0>, MOE_ALIGN, true, true>(lds + RING_OFF, g, S, E); }
#else
            pg8::Gemm g{act, moutt + (size_t)l * NE * 1024 * 1024, 1024, (size_t)1024 * 1024 * 2}; pg8::MoeOrder S; S.init(nru, 4, G, bx, ru2e, (LAS int*)(lds + LDSCTL_OFF + 3072)); S.build(tid); __syncthreads();
            pg8::EpiMoeOut E{yk, moe_b_out + (size_t)l * NE * 1024, row_asg, row_gate, 1.0f, (LAS float*)(lds + LDSCTL_OFF + 8192)};
            pg8::gemm_phase<pg8::EpiMoeOut, pg8::MoeOrder, true, true>(lds + RING_OFF, g, S, E); }
#endif
        SEAM(pb + 3);
        if (IN(pb + 4)) REPEAT_L1(9) { LAUNDER();
            if (l == 0) p_final<0>(Xb, Sb, ln_g + (size_t)(l * 2) * D, ln_b + (size_t)(l * 2) * D, yk, ln_g + (size_t)(l * 2 + 1) * D, ln_b + (size_t)(l * 2 + 1) * D, mod + modoff, mod + (size_t)16 * 6144, hq, (unsigned char*)x2b, d_outp, vcu, G, wave, lane);
            else p_final<1>(Xb, Sb, ln_g + (size_t)(l * 2) * D, ln_b + (size_t)(l * 2) * D, yk, ln_g + (size_t)(l * 2 + 1) * D, ln_b + (size_t)(l * 2 + 1) * D, mod + modoff, mod, hq, (unsigned char*)x2b, d_outp, vcu, G, wave, lane);
        }
        if (l == 0) SEAM(9);
    }
#undef IN
#undef SEAM
}
#undef xin
#undef cin
#undef mod
#undef meta
#undef act
#undef glu
#undef gates
#undef xs
#undef yk
#undef hq
#undef ot
#undef qt
#undef u2
#undef hA

extern "C" void kernel_launch(void* const* d_in, const int* in_sizes, int n_in, void* d_out, int out_size, void* d_ws, size_t ws_size, hipStream_t stream) {
    static int grid = 0;
    if (grid == 0) {
        if (n_in != 23 || in_sizes[0] != T * D || out_size != T * D || ws_size < WS_END) { fprintf(stderr, "kernel_launch: unexpected problem: n_in %d in0 %d out %d ws %zu (need %zu); nothing launched\n", n_in, n_in > 0 ? in_sizes[0] : -1, out_size, ws_size, (size_t)WS_END); grid = -1; return; }
        int dev = 0, cus = 0, per_cu = 0;
        if (hipGetDevice(&dev) != hipSuccess || hipDeviceGetAttribute(&cus, hipDeviceAttributeMultiprocessorCount, dev) != hipSuccess) { fprintf(stderr, "kernel_launch: device query failed\n"); grid = -1; return; }
        if (hipFuncSetAttribute((const void*)yoco_fwd, hipFuncAttributeMaxDynamicSharedMemorySize, LDS_BYTES) != hipSuccess) { fprintf(stderr, "kernel_launch: hipFuncSetAttribute failed\n"); grid = -1; return; }
        if (hipOccupancyMaxActiveBlocksPerMultiprocessor(&per_cu, (const void*)yoco_fwd, NTHREADS, LDS_BYTES) != hipSuccess || per_cu < 1)
            fprintf(stderr, "kernel_launch: note: occupancy query reports %d workgroups per CU\n", per_cu);
        (void)hipGetLastError();
        grid = cus;
        if (grid % 8 != 0 || grid > 256) { fprintf(stderr, "kernel_launch: built for <= 256 CUs in 8 XCDs, got %d\n", grid); }
    }
    if (grid < 0) return;
    if (hipMemsetAsync((char*)d_ws + WS_CTL, 0, CTL_ZERO_BYTES, stream) != hipSuccess) { fprintf(stderr, "kernel_launch: memset failed\n"); return; }
    Args a; memset(&a, 0, sizeof(a));
    for (int i = 0; i < 23; ++i) a.in[i] = (const float*)d_in[i];
    a.out = (float*)d_out; a.ws = (unsigned char*)d_ws;
#if MK_PER_PHASE
    for (int p = 0; p < N_PHASES; ++p) { a.ph_lo = p; a.ph_hi = p + 1; hipLaunchKernelGGL(yoco_fwd, dim3(grid), dim3(NTHREADS), LDS_BYTES, stream, a); }
#else
    a.ph_lo = 0; a.ph_hi = N_PHASES;
    hipLaunchKernelGGL(yoco_fwd, dim3(grid), dim3(NTHREADS), LDS_BYTES, stream, a);
#endif
    const hipError_t le = hipPeekAtLastError();
    if (le != hipSuccess) fprintf(stderr, "kernel_launch: launch failed: %s\n", hipGetErrorName(le));
}
```

```cpp
#include <hip/hip_runtime.h>
#include <cstdio>
#include <cstdint>
#include <cstring>

constexpr int T = 32768, D = 1024, NBATCH = 16, SEQ = 2048, NHEAD = 16, HDIM = 64, NE = 32, TOPK = 4, CONVW = 31;
constexpr int NASG = T * TOPK;
constexpr int APAD = NASG + NE * 256;
constexpr int MAXRU = APAD / 256;
constexpr float LN_EPS = 1e-5f;
constexpr float ALPHA_DN = 1.41421356237309515f;
constexpr float LOG2E = 1.4426950408889634f;

namespace pg8 {
#define PG8_LAS __attribute__((address_space(3)))
typedef unsigned short bf16_t;
typedef short bf16x8 __attribute__((ext_vector_type(8)));
typedef float f32x4 __attribute__((ext_vector_type(4)));
typedef unsigned u32x4 __attribute__((ext_vector_type(4)));
constexpr int BM = 256, BK = 64, HALF = 128, HTB = HALF * BK * 2  , STAGE_BYTES = 8 * HTB, NXCD = 8, WGM = 8;

__host__ __device__ __forceinline__ int lds_byte(int r, int c) { const int st = (r >> 4) * 2 + (c >> 5), rr = r & 15, cc = c & 31, ob = rr * 64 + cc * 2; return st * 1024 + (ob ^ (((ob >> 9) & 1) << 5)); }
__host__ __device__ __forceinline__ void stage_rc(int b, int& R, int& C) { const int st = b / 1024, sb = b % 1024, swz = sb ^ (((sb >> 9) & 1) << 5); R = (st >> 1) * 16 + swz / 64; C = (st & 1) * 32 + (swz % 64) / 2; }
__host__ __device__ __forceinline__ int perm32(int rho) { const int n = rho >> 4, i = rho & 15; return 8 * (i >> 2) + 4 * n + (i & 3); }

#ifndef GLDS_KEEP_M0
#define GLDS_KEEP_M0 0
#endif
template <int OFF> __device__ __forceinline__ void glds16_i(unsigned voff, const void* sbase, unsigned ldsbase) {
#if GLDS_KEEP_M0
    unsigned keep;
    asm volatile("s_mov_b32 %0, m0\n\ts_add_u32 m0, %3, %4\n\ts_nop 0\n\tglobal_load_lds_dwordx4 %1, %2\n\ts_mov_b32 m0, %0" : "=&s"(keep) : "v"(voff), "s"(sbase), "s"(ldsbase), "n"(OFF) : "memory", "scc");
#else
    asm volatile("s_add_u32 m0, %2, %3\n\ts_nop 0\n\tglobal_load_lds_dwordx4 %0, %1" :: "v"(voff), "s"(sbase), "s"(ldsbase), "n"(OFF) : "memory", "scc");
#endif
}
__device__ __forceinline__ void glds4(unsigned voff, const void* sbase, unsigned lds_dst) { unsigned keep;
    asm volatile("s_mov_b32 %0, m0\n\ts_mov_b32 m0, %3\n\ts_nop 0\n\tglobal_load_lds_dword %1, %2\n\ts_mov_b32 m0, %0" : "=&s"(keep) : "v"(voff), "s"(sbase), "s"(lds_dst) : "memory"); }
struct Unit { int pm, pn, e; };
struct Gemm { const bf16_t* A; const bf16_t* Bt; int K; size_t estride; const int* rowtok; PG8_LAS int* tab; };

struct StaticOrder {
    int nM, nN, nwg, G, c;
    __device__ void init(int M, int N, int G_, int c_) { nM = M / BM; nN = N / BM; nwg = nM * nN; G = G_; c = c_; }
    __device__ bool next(int i, Unit& u) const {
        const long L = (long)i * G + c; if (L >= nwg) return false;
        int wgid = (int)L; { const int q = nwg / NXCD, r = nwg % NXCD, xcd = wgid % NXCD, off = wgid / NXCD; wgid = (xcd < r ? xcd * (q + 1) : r * (q + 1) + (xcd - r) * q) + off; }
        const int nig = WGM * nN, gid = wgid / nig, fm = gid * WGM, gsz = (nM - fm) < WGM ? (nM - fm) : WGM;
        u.pm = fm + ((wgid % nig) % gsz); u.pn = (wgid % nig) / gsz; u.e = 0; return true;
    }
    __device__ __forceinline__ void a_ready(const Unit&) const {}
    __device__ __forceinline__ void done(const Unit&) const {}
    __device__ __forceinline__ void flush() const {}
};
#ifndef MOE_WGM
#define MOE_WGM 16
#endif
template <int HMODE> struct MoeOrderT {
    int nM, nN, nwg, G, c; const PG8_LAS int* ru2e; PG8_LAS int* utab;
    unsigned* cnt; unsigned need; int rot;
    __device__ void init(int nM_, int nN_, int G_, int c_, const PG8_LAS int* t, PG8_LAS int* ut) { nM = nM_; nN = nN_; nwg = nM * nN; G = G_; c = c_; ru2e = t; utab = ut; cnt = nullptr; need = 0u; rot = 0; allflag = nullptr; allneed = 0u; ncall = 0u; pend = -1; }
    __device__ void build(int tid) const {
        if (tid < 32) { const long L = (long)tid * G + c; int pm = 0, pn = 0, e = 0, ok = 0;
            if (L < nwg) { int wgid = (int)L; { const int q = nwg / NXCD, r = nwg % NXCD, xcd = wgid % NXCD; int off = wgid / NXCD; const int csz = q + (xcd < r ? 1 : 0);
                    if (HMODE == 2) { off += rot % csz; off = off >= csz ? off - csz : off; }
                    wgid = (xcd < r ? xcd * (q + 1) : r * (q + 1) + (xcd - r) * q) + off; }
                const int nig = MOE_WGM * nN, gid = wgid / nig, fm = gid * MOE_WGM, gsz = (nM - fm) < MOE_WGM ? (nM - fm) : MOE_WGM;
                pm = fm + ((wgid % nig) % gsz); pn = (wgid % nig) / gsz; e = ru2e[pm]; ok = 1; }
            utab[tid * 4] = pm; utab[tid * 4 + 1] = pn; utab[tid * 4 + 2] = e; utab[tid * 4 + 3] = ok; }
    }
    __device__ bool next(int i, Unit& u) const {
        if (i >= 32) return false;
        typedef int v4i_ __attribute__((ext_vector_type(4)));
        const v4i_ t = *(const PG8_LAS v4i_*)(utab + i * 4);
        if (__builtin_amdgcn_readfirstlane(t.w) == 0) return false;
        u.pm = __builtin_amdgcn_readfirstlane(t.x); u.pn = __builtin_amdgcn_readfirstlane(t.y); u.e = __builtin_amdgcn_readfirstlane(t.z); return true;
    }
    static constexpr int ALLW = 16000;
    PG8_LAS unsigned* allflag; unsigned allneed; mutable unsigned ncall;
    __device__ __forceinline__ void a_ready(const Unit& u) const {
        if constexpr (HMODE == 2) {
            const unsigned mycall = ncall++;
            if ((unsigned)__builtin_amdgcn_readfirstlane((int)*allflag) <= mycall) return;
            if (threadIdx.x < 64) { unsigned sp = 0u;
                while ((unsigned)__builtin_amdgcn_readfirstlane((int)__hip_atomic_load(cnt + 16 * u.pm, __ATOMIC_RELAXED, __HIP_MEMORY_SCOPE_AGENT)) < need) { __builtin_amdgcn_s_sleep(2); if (++sp > (1u << 21)) break; }
                const unsigned alld = (unsigned)__builtin_amdgcn_readfirstlane((int)__hip_atomic_load(cnt + ALLW, __ATOMIC_RELAXED, __HIP_MEMORY_SCOPE_AGENT));
                __builtin_amdgcn_fence(__ATOMIC_ACQUIRE, "agent");
                asm volatile("s_waitcnt vmcnt(0)" ::: "memory");
                if (alld >= allneed && threadIdx.x == 0) *allflag = mycall + 1u; }
            asm volatile("" ::: "memory"); __builtin_amdgcn_s_barrier(); asm volatile("" ::: "memory");
        }
    }
    mutable int pend;
    __device__ __forceinline__ void done(const Unit& u) const { if constexpr (HMODE == 1) { if (pend >= 0) { asm volatile("s_waitcnt vmcnt(0)" ::: "memory"); flush(); }     pend = u.pm; } }
    __device__ __forceinline__ void flush() const {
        if constexpr (HMODE == 1) { if (pend >= 0) { if ((threadIdx.x & 63) == 0) (void)__hip_atomic_fetch_add(cnt + 16 * pend, 1u, __ATOMIC_RELAXED, __HIP_MEMORY_SCOPE_AGENT); pend = -1; } }
    }
};
typedef MoeOrderT<0> MoeOrder;

typedef float f32x2_t __attribute__((ext_vector_type(2))); typedef __bf16 bf16x2_t __attribute__((ext_vector_type(2)));
__device__ __forceinline__ unsigned cvt_pk_bf16(float lo, float hi) { f32x2_t v = {lo, hi}; bf16x2_t b = __builtin_convertvector(v, bf16x2_t); return __builtin_bit_cast(unsigned, b); }
#ifndef MOE_HANDOFF
#define MOE_HANDOFF 1
#endif
#ifndef WT_STORES
#define WT_STORES 0
#endif
__device__ __forceinline__ const unsigned char* ws_base_() {
    unsigned off = 192u; asm volatile("" : "+s"(off));
    const __attribute__((address_space(4))) char* kp = (const __attribute__((address_space(4))) char*)__builtin_amdgcn_kernarg_segment_ptr();
    return (const unsigned char*)(const __attribute__((address_space(1))) void*)(*(const __attribute__((address_space(4))) unsigned long long*)(kp + off));
}
__device__ __forceinline__ __amdgpu_buffer_rsrc_t ws_rsrc_() { return __builtin_amdgcn_make_buffer_rsrc((void*)ws_base_(), 0, 0x7fffffff, 0x00020000); }
__device__ __forceinline__ int ws_off_(const void* p) { return (int)((unsigned)(size_t)p - (unsigned)(size_t)ws_base_()); }
__device__ __forceinline__ void st16_plain(void* p, u32x4 v) { *(u32x4*)p = v; }
__device__ __forceinline__ void st16_wt(void* p, u32x4 v) { __builtin_amdgcn_raw_buffer_store_b128(v, ws_rsrc_(), ws_off_(p), 0, 16); }
__device__ __forceinline__ void st16(void* p, u32x4 v) {
#if WT_STORES == 2
    __builtin_amdgcn_raw_buffer_store_b128(v, ws_rsrc_(), ws_off_(p), 0, 16);
#else
    *(u32x4*)p = v;
#endif
}
typedef unsigned u32x2s_t __attribute__((ext_vector_type(2)));
__device__ __forceinline__ void st8(void* p, u32x2s_t v) {
#if WT_STORES == 2
    __builtin_amdgcn_raw_buffer_store_b64(v, ws_rsrc_(), ws_off_(p), 0, 16);
#else
    *(u32x2s_t*)p = v;
#endif
}
__device__ __forceinline__ void st4(void* p, unsigned v) {
#if WT_STORES == 2
    __builtin_amdgcn_raw_buffer_store_b32(v, ws_rsrc_(), ws_off_(p), 0, 16);
#else
    *(unsigned*)p = v;
#endif
}
__device__ __forceinline__ void st2(void* p, unsigned short v) {
#if WT_STORES == 2
    __builtin_amdgcn_raw_buffer_store_b16(v, ws_rsrc_(), ws_off_(p), 0, 16);
#else
    *(unsigned short*)p = v;
#endif
}
__device__ __forceinline__ void st1(void* p, unsigned char v) {
#if WT_STORES == 2
    __builtin_amdgcn_raw_buffer_store_b8(v, ws_rsrc_(), ws_off_(p), 0, 16);
#else
    *(unsigned char*)p = v;
#endif
}
__device__ __forceinline__ float sigmoidf_(float x) { return __builtin_amdgcn_rcpf(1.0f + __builtin_amdgcn_exp2f(-x * LOG2E)); }

typedef int v8i_t __attribute__((ext_vector_type(8))); typedef int v4i_t __attribute__((ext_vector_type(4)));
__device__ __forceinline__ v8i_t cat8(const bf16x8& lo, const bf16x8& hi) { const v4i_t a = __builtin_bit_cast(v4i_t, lo), b = __builtin_bit_cast(v4i_t, hi); return __builtin_shufflevector(a, b, 0, 1, 2, 3, 4, 5, 6, 7); }
__device__ __forceinline__ void mfma_fp8_acc(f32x4& acc, const v8i_t a, const v8i_t b, unsigned sc) {
    asm volatile("v_mfma_scale_f32_16x16x128_f8f6f4 %0, %1, %2, %0, %3, %3 op_sel_hi:[0,0,0]" : "+v"(acc) : "v"(a), "v"(b), "v"(sc)); }
__device__ __forceinline__ float clamp448(float v) { return __builtin_amdgcn_fmed3f(v, -448.0f, 448.0f); }
__device__ __forceinline__ unsigned pk4_fp8(float a, float b, float c, float d) { unsigned w = 0u; w = __builtin_amdgcn_cvt_pk_fp8_f32(clamp448(a), clamp448(b), w, false); w = __builtin_amdgcn_cvt_pk_fp8_f32(clamp448(c), clamp448(d), w, true); return w; }
__device__ __forceinline__ unsigned pk4_fp8_nc(float a, float b, float c, float d) { unsigned w = 0u; w = __builtin_amdgcn_cvt_pk_fp8_f32(a, b, w, false); w = __builtin_amdgcn_cvt_pk_fp8_f32(c, d, w, true); return w; }
typedef unsigned u32x2_t __attribute__((ext_vector_type(2)));

struct EpiBf16 {
    static constexpr bool PERM = true, AFTER_DRAIN = false, PREFETCH = false, BPERM2 = false;
    bf16_t* O; int ldc; float scale;
    __device__ __forceinline__ void operator()(const f32x4 (&acc)[2][2][4][2], const Unit& u, int wr, int wc, int fr, int fq) const {
        const int row0 = u.pm * BM + wr * 64 + fr, col0 = u.pn * BM + wc * 32 + 8 * fq;
#pragma unroll
        for (int ai = 0; ai < 2; ++ai)
#pragma unroll
            for (int m = 0; m < 4; ++m) { bf16_t* rowp = O + (size_t)(row0 + ai * HALF + m * 16) * ldc + col0;
#pragma unroll
                for (int bj = 0; bj < 2; ++bj) { const f32x4 v0 = acc[ai][bj][m][0] * scale, v1 = acc[ai][bj][m][1] * scale;
                    u32x4 w; w.x = cvt_pk_bf16(v0[0], v0[1]); w.y = cvt_pk_bf16(v0[2], v0[3]); w.z = cvt_pk_bf16(v1[0], v1[1]); w.w = cvt_pk_bf16(v1[2], v1[3]);
                    st16(rowp + bj * HALF, w); } }
    }
};
template <int MODE> struct EpiGlu {
    static constexpr bool PERM = true, AFTER_DRAIN = false, PREFETCH = (MODE == 2), BPERM2 = false;
    bf16_t* O; const float* bias; float accs, outs; PG8_LAS float* tab;
    __device__ __forceinline__ void prefetch(const Unit& u, int par, int tid, int wid) const {
        if (wid < 4) glds4((unsigned)(tid & 63) * 4u, (const void*)(bias + (size_t)u.e * 2048 + (wid >> 1) * 1024 + u.pn * HALF + (wid & 1) * 64), (unsigned)(size_t)(tab + par * 256) + (unsigned)wid * 256u);
    }
    __device__ __forceinline__ void operator()(const f32x4 (&acc)[2][2][4][2], const Unit& u, int wr, int wc, int fr, int fq, int par = 0) const {
        const int row0 = u.pm * BM + wr * 64 + fr, j0 = u.pn * HALF + wc * 32 + 8 * fq;
        const float* bp = bias + (size_t)u.e * 2048;
        f32x4 ba[2], bg[2];
        if (MODE == 2) { const PG8_LAS float* tb = tab + par * 256 + wc * 32 + 8 * fq;
#pragma unroll
            for (int n = 0; n < 2; ++n) { ba[n] = *(const PG8_LAS f32x4*)(tb + 4 * n); bg[n] = *(const PG8_LAS f32x4*)(tb + 128 + 4 * n); } }
        else {
#pragma unroll
            for (int n = 0; n < 2; ++n) { ba[n] = *(const f32x4*)(bp + j0 + 4 * n); bg[n] = *(const f32x4*)(bp + 1024 + j0 + 4 * n); } }
        u32x2_t wprev = {0u, 0u};
#pragma unroll
        for (int ai = 0; ai < 2; ++ai)
#pragma unroll
            for (int m = 0; m < 4; ++m) { bf16_t* rowp = O + (size_t)(row0 + ai * HALF + m * 16) * 1024 + j0;
                float o[8];
#pragma unroll
                for (int n = 0; n < 2; ++n) {
                    if (MODE == 0) { const f32x4 a = acc[ai][0][m][n] * accs + ba[n], g = acc[ai][1][m][n] * accs + bg[n];
#pragma unroll
                        for (int i = 0; i < 4; ++i) o[4 * n + i] = a[i] * sigmoidf_(g[i]); }
                    else {
#pragma unroll
                        for (int q = 0; q < 2; ++q) {
                            const f32x2_t a2 = (f32x2_t){acc[ai][0][m][n][2 * q], acc[ai][0][m][n][2 * q + 1]} * accs + (f32x2_t){ba[n][2 * q], ba[n][2 * q + 1]};
                            const f32x2_t g2 = (f32x2_t){acc[ai][1][m][n][2 * q], acc[ai][1][m][n][2 * q + 1]} * accs + (f32x2_t){bg[n][2 * q], bg[n][2 * q + 1]};
                            const f32x2_t xg = {fminf(a2.x, 7.0f), fminf(a2.y, 7.0f)}, xl = {__builtin_amdgcn_fmed3f(g2.x, -7.0f, 7.0f), __builtin_amdgcn_fmed3f(g2.y, -7.0f, 7.0f)};
                            const f32x2_t t2 = xg * (-1.702f * LOG2E); const f32x2_t d2 = (f32x2_t){__builtin_amdgcn_exp2f(t2.x), __builtin_amdgcn_exp2f(t2.y)} + 1.0f;
                            const f32x2_t sg = {__builtin_amdgcn_rcpf(d2.x), __builtin_amdgcn_rcpf(d2.y)};
                            const f32x2_t r2 = (xl * outs + outs) * (xg * sg);
                            o[4 * n + 2 * q] = r2.x; o[4 * n + 2 * q + 1] = r2.y; } } }
                if (MODE == 2) { u32x2_t w; w.x = pk4_fp8_nc(o[0], o[1], o[2], o[3]); w.y = pk4_fp8_nc(o[4], o[5], o[6], o[7]);
                    if ((m & 1) == 0) wprev = w;
                    else { const auto sx = __builtin_amdgcn_permlane16_swap(wprev.x, w.x, false, false), sy = __builtin_amdgcn_permlane16_swap(wprev.y, w.y, false, false);
                        u32x4 o4; o4.x = sx[0]; o4.y = sy[0]; o4.z = sx[1]; o4.w = sy[1];
                        { void* op_ = (unsigned char*)O + (size_t)(row0 + ai * HALF + (m - 1) * 16 + ((fq & 1) ? 16 : 0)) * 1024 + u.pn * HALF + wc * 32 + 8 * (fq & ~1);
                          if (MOE_HANDOFF) st16_wt(op_, o4); else st16(op_, o4); } } }
                else { u32x4 w; w.x = cvt_pk_bf16(o[0], o[1]); w.y = cvt_pk_bf16(o[2], o[3]); w.z = cvt_pk_bf16(o[4], o[5]); w.w = cvt_pk_bf16(o[6], o[7]);
                st16(rowp, w); } }
    }
};
template <bool XBF> struct EpiResid {
    static constexpr bool PERM = true, AFTER_DRAIN = false, PREFETCH = false, BPERM2 = false;
    const void* x; bf16_t* S; const float* bias; const float* gate; float accs;
    __device__ __forceinline__ void operator()(const f32x4 (&acc)[2][2][4][2], const Unit& u, int wr, int wc, int fr, int fq) const {
        const int col0 = u.pn * BM + wc * 32 + 8 * fq, b = (u.pm * BM) >> 11;
#pragma unroll
        for (int bj = 0; bj < 2; ++bj) { const int c = col0 + bj * HALF;
            f32x4 bv[2], gv[2];
#pragma unroll
            for (int n = 0; n < 2; ++n) { bv[n] = bias ? *(const f32x4*)(bias + c + 4 * n) : (f32x4){0.f, 0.f, 0.f, 0.f}; gv[n] = *(const f32x4*)(gate + (size_t)b * 6144 + c + 4 * n) + 1.0f; }
            constexpr int NAI = XBF ? 2 : 1;
#pragma unroll
            for (int a0 = 0; a0 < 2; a0 += NAI) {
            u32x4 xr[NAI][4][XBF ? 1 : 2];
#pragma unroll
            for (int ai = 0; ai < NAI; ++ai)
#pragma unroll
                for (int m = 0; m < 4; ++m) { const size_t off = (size_t)(u.pm * BM + (a0 + ai) * HALF + wr * 64 + m * 16 + fr) * 1024 + c;
                    if (XBF) xr[ai][m][0] = *(const u32x4*)((const bf16_t*)x + off);
                    else { xr[ai][m][0] = *(const u32x4*)((const float*)x + off); xr[ai][m][XBF ? 0 : 1] = *(const u32x4*)((const float*)x + off + 4); } }
#pragma unroll
            for (int ai = 0; ai < NAI; ++ai)
#pragma unroll
                for (int m = 0; m < 4; ++m) { const size_t off = (size_t)(u.pm * BM + (a0 + ai) * HALF + wr * 64 + m * 16 + fr) * 1024 + c;
                    f32x4 x0, x1;
                    if (XBF) { const u32x4 w = xr[ai][m][0];
                        x0 = (f32x4){__uint_as_float(w.x << 16), __uint_as_float(w.x & 0xffff0000u), __uint_as_float(w.y << 16), __uint_as_float(w.y & 0xffff0000u)};
                        x1 = (f32x4){__uint_as_float(w.z << 16), __uint_as_float(w.z & 0xffff0000u), __uint_as_float(w.w << 16), __uint_as_float(w.w & 0xffff0000u)}; }
                    else { x0 = __builtin_bit_cast(f32x4, xr[ai][m][0]); x1 = __builtin_bit_cast(f32x4, xr[ai][m][XBF ? 0 : 1]); }
                    const f32x4 s0 = x0 * ALPHA_DN + gv[0] * (acc[a0 + ai][bj][m][0] * accs + bv[0]), s1 = x1 * ALPHA_DN + gv[1] * (acc[a0 + ai][bj][m][1] * accs + bv[1]);
                    u32x4 o; o.x = cvt_pk_bf16(s0[0], s0[1]); o.y = cvt_pk_bf16(s0[2], s0[3]); o.z = cvt_pk_bf16(s1[0], s1[1]); o.w = cvt_pk_bf16(s1[2], s1[3]);
                    st16(S + off, o); } } }
    }
};
#ifndef YK_FP8
#define YK_FP8 1
#endif
constexpr float YK_S = 64.0f;
struct EpiMoeOut {
    static constexpr bool PERM = true, AFTER_DRAIN = false, PREFETCH = true, BPERM2 = (YK_FP8 != 0);
    bf16_t* Y; const float* bias; const int* row_asg; const float* row_gate; float accs; PG8_LAS float* tab;
    __device__ __forceinline__ void prefetch(const Unit& u, int par, int tid, int wid) const {
        if (wid < 4) { const unsigned vo = (unsigned)(tid & 63) * 4u, dst = (unsigned)(size_t)(tab + par * 768) + (unsigned)wid * 256u;
            glds4(vo, (const void*)(bias + (size_t)u.e * 1024 + u.pn * BM + wid * 64), dst);
            glds4(vo, (const void*)(row_asg + (size_t)u.pm * BM + wid * 64), dst + 1024u);
            glds4(vo, (const void*)(row_gate + (size_t)u.pm * BM + wid * 64), dst + 2048u); }
    }
    __device__ __forceinline__ void operator()(const f32x4 (&acc)[2][2][4][2], const Unit& u, int wr, int wc, int fr, int fq, int par = 0) const {
        const PG8_LAS float* tb = tab + par * 768;
#if YK_FP8
        const int cl = wc * 64 + 16 * fq;
        f32x4 bv[4];
#pragma unroll
        for (int q = 0; q < 4; ++q) bv[q] = *(const PG8_LAS f32x4*)(tb + cl + 4 * q);
#pragma unroll
        for (int ai = 0; ai < 2; ++ai)
#pragma unroll
            for (int m = 0; m < 4; ++m) { const int rl = ai * HALF + wr * 64 + m * 16 + fr; const int drow = ((const PG8_LAS int*)tb)[256 + rl]; const float g = tb[512 + rl] * YK_S;
                if (drow >= 0) { u32x4 o;
                    { const f32x4 v = (acc[ai][0][m][0] * accs + bv[0]) * g; o.x = pk4_fp8(v[0], v[1], v[2], v[3]); }
                    { const f32x4 v = (acc[ai][0][m][1] * accs + bv[1]) * g; o.y = pk4_fp8(v[0], v[1], v[2], v[3]); }
                    { const f32x4 v = (acc[ai][1][m][0] * accs + bv[2]) * g; o.z = pk4_fp8(v[0], v[1], v[2], v[3]); }
                    { const f32x4 v = (acc[ai][1][m][1] * accs + bv[3]) * g; o.w = pk4_fp8(v[0], v[1], v[2], v[3]); }
                    st16((unsigned char*)Y + (size_t)drow * 1024 + u.pn * BM + cl, o); } }
#else
        const int col0 = u.pn * BM + wc * 32 + 8 * fq;
        int dst[2][4]; float gt[2][4];
#pragma unroll
        for (int ai = 0; ai < 2; ++ai)
#pragma unroll
            for (int m = 0; m < 4; ++m) { const int rl = ai * HALF + wr * 64 + m * 16 + fr; dst[ai][m] = ((const PG8_LAS int*)tb)[256 + rl]; gt[ai][m] = tb[512 + rl]; }
        f32x4 bv[2][2];
#pragma unroll
        for (int bj = 0; bj < 2; ++bj)
#pragma unroll
            for (int n = 0; n < 2; ++n) bv[bj][n] = *(const PG8_LAS f32x4*)(tb + wc * 32 + 8 * fq + bj * HALF + 4 * n);
#pragma unroll
        for (int ai = 0; ai < 2; ++ai)
#pragma unroll
            for (int m = 0; m < 4; ++m) {
                if (dst[ai][m] >= 0) {
#pragma unroll
                    for (int bj = 0; bj < 2; ++bj) { const f32x4 v0 = (acc[ai][bj][m][0] * accs + bv[bj][0]) * gt[ai][m], v1 = (acc[ai][bj][m][1] * accs + bv[bj][1]) * gt[ai][m];
                        u32x4 w; w.x = cvt_pk_bf16(v0[0], v0[1]); w.y = cvt_pk_bf16(v0[2], v0[3]); w.z = cvt_pk_bf16(v1[0], v1[1]); w.w = cvt_pk_bf16(v1[2], v1[3]);
                        *(u32x4*)(Y + (size_t)dst[ai][m] * 1024 + col0 + bj * HALF) = w;
                    } } }
#endif
    }
};

#ifndef PG8_TAB_IN_SHADOW
#define PG8_TAB_IN_SHADOW 1
#endif
#ifndef PG8_B1LATE
#define PG8_B1LATE 0
#endif
template <class Epi, class Sched, bool ALIGN_EPI = false, bool SP2 = false, bool FP8 = false, bool GATHER = false>
__device__ __forceinline__ void gemm_phase(PG8_LAS unsigned char* lds, const Gemm g, const Sched& S, const Epi& E) {
    int tid_l = threadIdx.x; asm volatile("" : "+v"(tid_l));
    const int tid = tid_l, wid = __builtin_amdgcn_readfirstlane(tid >> 6), lane = tid & 63, wr = wid >> 2, wc = wid & 3, fr = lane & 15, fq = lane >> 4;
    const int K = g.K, nt = K / BK;
    unsigned voffA[2], voffB[2], voffB1[2];
#pragma unroll
    for (int i = 0; i < 2; ++i) { int R, C; stage_rc(tid * 16 + i * 8192, R, C); const int Rb = Epi::PERM ? ((R & ~31) + perm32(R & 31)) : R;
        voffA[i] = (unsigned)(R * K + C) * 2u; voffB[i] = (unsigned)(Rb * K + C) * 2u; voffB1[i] = voffB[i];
        if constexpr (Epi::BPERM2) { const int p = perm32(R & 31), Rb2 = 64 * (R >> 5) + 2 * (p & ~7) + (p & 7); voffB[i] = (unsigned)(Rb2 * K + C) * 2u; voffB1[i] = (unsigned)((Rb2 + 8) * K + C) * 2u; } }
    const size_t kstep = (size_t)(BK * 2);
    const size_t hstep = (size_t)HALF * K * 2;
    const size_t tstep = 2 * hstep;
    const unsigned ldsw = (unsigned)wid * 1024u;
    unsigned scv = 0x7f7f7f7fu; asm volatile("" : "+v"(scv));
    (void)scv;
    const unsigned ldsbase = (unsigned)__builtin_amdgcn_readfirstlane((int)((unsigned)(size_t)lds + ldsw));
    const int aoff = lds_byte(wr * 64 + fr, fq * 8), boff = lds_byte(wc * 32 + fr, fq * 8);
#define PG8_SA(b, h) (((b) * 2 + (h)) * HTB)
#define PG8_SB(b, h) ((4 + (b) * 2 + (h)) * HTB)
#define PG8_STAGE(bufoff, gbase, voff) do { glds16_i<(bufoff)>((voff)[0], (const void*)(gbase), ldsbase); glds16_i<(bufoff) + 8192>((voff)[1], (const void*)(gbase), ldsbase); } while (0)
#define PG8_LDA(dst, b, h) do { _Pragma("unroll") for (int m = 0; m < 4; ++m) _Pragma("unroll") for (int k = 0; k < 2; ++k) dst[m][k] = *(const PG8_LAS bf16x8*)(lds + PG8_SA(b, h) + aoff + m * 2048 + k * 1024); } while (0)
#define PG8_LDB(dst, b, h) do { _Pragma("unroll") for (int n = 0; n < 2; ++n) _Pragma("unroll") for (int k = 0; k < 2; ++k) dst[n][k] = *(const PG8_LAS bf16x8*)(lds + PG8_SB(b, h) + boff + n * 2048 + k * 1024); } while (0)
#define PG8_MMA(ai, bj, At, Bt) do { __builtin_amdgcn_s_setprio(1); \
        if constexpr (FP8) { _Pragma("unroll") for (int m = 0; m < 4; ++m) _Pragma("unroll") for (int n = 0; n < 2; ++n) \
            mfma_fp8_acc(acc[ai][bj][m][n], cat8(Bt[n][0], Bt[n][1]), cat8(At[m][0], At[m][1]), scv); } \
        else { _Pragma("unroll") for (int m = 0; m < 4; ++m) _Pragma("unroll") for (int n = 0; n < 2; ++n) _Pragma("unroll") for (int k = 0; k < 2; ++k) \
            acc[ai][bj][m][n] = __builtin_amdgcn_mfma_f32_16x16x32_bf16(Bt[n][k], At[m][k], acc[ai][bj][m][n], 0, 0, 0); } \
        __builtin_amdgcn_s_setprio(0); } while (0)
#define PG8_WAIT_V(n) asm volatile("s_waitcnt vmcnt(" #n ")" ::: "memory")
#define PG8_WAIT_L(n) asm volatile("s_waitcnt lgkmcnt(" #n ")" ::: "memory")
#define PG8_BAR __builtin_amdgcn_s_barrier()
#define PG8_SCHED __builtin_amdgcn_sched_barrier(0)
    Unit cur, nxt; int ui = 0;
    if (!S.next(0, cur)) return;
    f32x4 acc[2][2][4][2];
#pragma unroll
    for (int a = 0; a < 2; ++a)
#pragma unroll
        for (int b = 0; b < 2; ++b)
#pragma unroll
            for (int m = 0; m < 4; ++m)
#pragma unroll
                for (int n = 0; n < 2; ++n) acc[a][b][m][n] = (f32x4){0.f, 0.f, 0.f, 0.f};
    bf16x8 At[4][2], B0[2][2], B1[2][2];
    static_assert(!GATHER || SP2, "the gathered-A form exists for the SP2 loop only");
    const char* cA = GATHER ? (const char*)g.A : (const char*)g.A + (size_t)cur.pm * tstep; const char* cB = (const char*)g.Bt + (size_t)cur.e * g.estride + (size_t)cur.pn * tstep;
    const size_t hstepB = Epi::BPERM2 ? 0 : hstep;
    static_assert(!Epi::BPERM2 || SP2, "BPERM2 exists for the SP2 loop only");
    const size_t hstepA = GATHER ? 0 : hstep;
    unsigned cvA[2][2], nvA[2][2]; int tabi[2][2]; unsigned cofs[2];
    if constexpr (GATHER) {
#pragma unroll
        for (int i = 0; i < 2; ++i) { int R, C; stage_rc(tid * 16 + i * 8192, R, C); cofs[i] = (unsigned)C * 2u; tabi[0][i] = R; tabi[1][i] = HALF + R; }
        __syncthreads();
        if (tid < BM) g.tab[tid] = g.rowtok[cur.pm * BM + tid];
        __syncthreads();
#pragma unroll
        for (int h = 0; h < 2; ++h)
#pragma unroll
            for (int i = 0; i < 2; ++i) { cvA[h][i] = (unsigned)g.tab[tabi[h][i]] * (unsigned)(K * 2) + cofs[i]; nvA[h][i] = cvA[h][i]; }
    } else {
#pragma unroll
        for (int h = 0; h < 2; ++h)
#pragma unroll
            for (int i = 0; i < 2; ++i) { cvA[h][i] = voffA[i]; nvA[h][i] = voffA[i]; tabi[h][i] = 0; }
        cofs[0] = cofs[1] = 0u;
    }
    S.a_ready(cur);
    if constexpr (SP2) {
        PG8_STAGE(PG8_SB(0, 0), cB, voffB); PG8_STAGE(PG8_SB(0, 1), cB + hstepB, voffB1); PG8_STAGE(PG8_SA(0, 0), cA, cvA[0]); PG8_STAGE(PG8_SA(0, 1), cA + hstepA, cvA[1]);
        if (wr == 1) PG8_BAR;
        PG8_WAIT_V(2); PG8_BAR;
        PG8_STAGE(PG8_SB(1, 0), cB + kstep, voffB); PG8_STAGE(PG8_SA(1, 0), cA + kstep, cvA[0]); PG8_STAGE(PG8_SB(1, 1), cB + hstepB + kstep, voffB1);
        PG8_WAIT_V(6); PG8_BAR;
    } else {
        PG8_STAGE(PG8_SB(0, 0), cB, voffB); PG8_STAGE(PG8_SA(0, 0), cA, voffA); PG8_STAGE(PG8_SB(0, 1), cB + hstep, voffB); PG8_STAGE(PG8_SA(0, 1), cA + hstep, voffA);
        if (wr == 1) PG8_BAR;
        PG8_WAIT_V(4); PG8_BAR;
        PG8_STAGE(PG8_SB(1, 0), cB + kstep, voffB); PG8_STAGE(PG8_SA(1, 0), cA + kstep, voffA); PG8_STAGE(PG8_SB(1, 1), cB + hstep + kstep, voffB);
        PG8_WAIT_V(6); PG8_BAR;
    }
    for (;;) {
        const bool has_next = S.next(ui + 1, nxt);
        const char* nA = (has_next && !GATHER) ? (const char*)g.A + (size_t)nxt.pm * tstep : cA; const char* nB = has_next ? (const char*)g.Bt + (size_t)nxt.e * g.estride + (size_t)nxt.pn * tstep : cB;
#if defined(PROBE_KLOOP2)
        const int nt2_ = (FP8 == (PROBE_KLOOP2 == 1)) ? 2 * nt : nt;
#else
        const int nt2_ = nt;
#endif
#pragma clang loop unroll(disable)
        for (int tt_ = 0; tt_ < nt2_; tt_ += 2) {
            const int t = tt_ >= nt ? tt_ - nt : tt_;
            const bool pass_end = (t == nt - 2), last = pass_end && (tt_ == nt2_ - 2);
            const char* a1 = cA + (size_t)(t + 1) * kstep;
            const char* a2 = last ? nA : (pass_end ? cA : cA + (size_t)(t + 2) * kstep); const char* b2 = last ? nB : (pass_end ? cB : cB + (size_t)(t + 2) * kstep);
            const char* a3 = a2 + kstep; const char* b3 = b2 + kstep;
            if (last && has_next) S.a_ready(nxt);
#if !PG8_TAB_IN_SHADOW
            if constexpr (Epi::PREFETCH) { if (t == 0) E.prefetch(cur, ui & 1, tid, wid); }
#endif
            if (t == 4) S.flush();
            unsigned sA[2][2];
            if constexpr (GATHER) {
#if !PG8_TAB_IN_SHADOW
                if (t == 0 && has_next && wid < 4) glds4((unsigned)tid * 4u, (const void*)(g.rowtok + (size_t)nxt.pm * BM), (unsigned)(size_t)(g.tab + ((ui + 1) & 1) * BM) + (unsigned)wid * 256u);
#endif
                const PG8_LAS int* tb = g.tab + ((ui + 1) & 1) * BM;
                if (last && has_next) {
#pragma unroll
                    for (int h = 0; h < 2; ++h)
#pragma unroll
                        for (int i = 0; i < 2; ++i) { nvA[h][i] = (unsigned)tb[tabi[h][i]] * (unsigned)(K * 2) + cofs[i]; sA[h][i] = nvA[h][i]; } }
                else {
#pragma unroll
                    for (int h = 0; h < 2; ++h)
#pragma unroll
                        for (int i = 0; i < 2; ++i) sA[h][i] = cvA[h][i]; }
            } else {
#pragma unroll
                for (int h = 0; h < 2; ++h)
#pragma unroll
                    for (int i = 0; i < 2; ++i) sA[h][i] = voffA[i];
            }
            if constexpr (SP2) {
#if PG8_B1LATE
            PG8_LDB(B0, 0, 0); PG8_SCHED; PG8_LDA(At, 0, 0); PG8_STAGE(PG8_SA(1, 1), a1 + hstepA, cvA[1]);
            if (t == 0) {
#pragma unroll
                for (int a_ = 0; a_ < 2; ++a_)
#pragma unroll
                    for (int b_ = 0; b_ < 2; ++b_)
#pragma unroll
                        for (int m_ = 0; m_ < 4; ++m_)
#pragma unroll
                            for (int n_ = 0; n_ < 2; ++n_) acc[a_][b_][m_][n_] = (f32x4){0.f, 0.f, 0.f, 0.f}; }
            PG8_WAIT_V(8); PG8_WAIT_L(0); PG8_BAR; PG8_LDB(B1, 0, 1); PG8_SCHED; PG8_MMA(0, 0, At, B0); PG8_MMA(0, 1, At, B1); PG8_BAR; PG8_SCHED;
            PG8_LDA(At, 0, 1); PG8_STAGE(PG8_SB(0, 0), b2, voffB); PG8_STAGE(PG8_SA(0, 0), a2, sA[0]);
            PG8_WAIT_V(6); PG8_WAIT_L(0); PG8_BAR; PG8_STAGE(PG8_SB(0, 1), b2 + hstepB, voffB1); PG8_MMA(1, 0, At, B0); PG8_MMA(1, 1, At, B1); PG8_BAR; PG8_SCHED;
            PG8_LDB(B0, 1, 0); PG8_SCHED; PG8_LDA(At, 1, 0); PG8_STAGE(PG8_SA(0, 1), a2 + hstepA, sA[1]);
            PG8_WAIT_V(8); PG8_WAIT_L(0); PG8_BAR; PG8_LDB(B1, 1, 1); PG8_SCHED; PG8_MMA(0, 0, At, B0); PG8_MMA(0, 1, At, B1); PG8_BAR; PG8_SCHED;
            PG8_LDA(At, 1, 1); PG8_STAGE(PG8_SB(1, 0), b3, voffB); PG8_STAGE(PG8_SA(1, 0), a3, sA[0]);
            PG8_WAIT_V(6); PG8_WAIT_L(0); PG8_BAR; PG8_STAGE(PG8_SB(1, 1), b3 + hstepB, voffB1); PG8_MMA(1, 0, At, B0); PG8_MMA(1, 1, At, B1); PG8_BAR; PG8_SCHED;
#else
            PG8_LDB(B0, 0, 0); PG8_LDB(B1, 0, 1); PG8_SCHED; PG8_LDA(At, 0, 0); PG8_STAGE(PG8_SA(1, 1), a1 + hstepA, cvA[1]);
            if (t == 0) {
#pragma unroll
                for (int m_ = 0; m_ < 4; ++m_)
#pragma unroll
                    for (int n_ = 0; n_ < 2; ++n_) acc[0][0][m_][n_] = (f32x4){0.f, 0.f, 0.f, 0.f}; }
            PG8_WAIT_V(8); PG8_WAIT_L(0); PG8_BAR; PG8_MMA(0, 0, At, B0);
            if (t == 0) {
#pragma unroll
                for (int m_ = 0; m_ < 4; ++m_)
#pragma unroll
                    for (int n_ = 0; n_ < 2; ++n_) acc[0][1][m_][n_] = (f32x4){0.f, 0.f, 0.f, 0.f};
#if PG8_TAB_IN_SHADOW
                if constexpr (Epi::PREFETCH) E.prefetch(cur, ui & 1, tid, wid);
                if constexpr (GATHER) { if (has_next && wid < 4) glds4((unsigned)tid * 4u, (const void*)(g.rowtok + (size_t)nxt.pm * BM), (unsigned)(size_t)(g.tab + ((ui + 1) & 1) * BM) + (unsigned)wid * 256u); }
#endif
            }
            PG8_MMA(0, 1, At, B1); PG8_BAR; PG8_SCHED;
            PG8_LDA(At, 0, 1); PG8_STAGE(PG8_SB(0, 0), b2, voffB); PG8_STAGE(PG8_SB(0, 1), b2 + hstepB, voffB1); PG8_STAGE(PG8_SA(0, 0), a2, sA[0]);
            if (t == 0) {
#pragma unroll
                for (int m_ = 0; m_ < 4; ++m_)
#pragma unroll
                    for (int n_ = 0; n_ < 2; ++n_) acc[1][0][m_][n_] = (f32x4){0.f, 0.f, 0.f, 0.f}; }
            PG8_WAIT_V(8); PG8_WAIT_L(0); PG8_BAR; PG8_MMA(1, 0, At, B0);
            if (t == 0) {
#pragma unroll
                for (int m_ = 0; m_ < 4; ++m_)
#pragma unroll
                    for (int n_ = 0; n_ < 2; ++n_) acc[1][1][m_][n_] = (f32x4){0.f, 0.f, 0.f, 0.f}; }
            PG8_MMA(1, 1, At, B1); PG8_BAR; PG8_SCHED;
            PG8_LDB(B0, 1, 0); PG8_LDB(B1, 1, 1); PG8_SCHED; PG8_LDA(At, 1, 0); PG8_STAGE(PG8_SA(0, 1), a2 + hstepA, sA[1]);
            PG8_WAIT_V(8); PG8_WAIT_L(0); PG8_BAR; PG8_MMA(0, 0, At, B0); PG8_MMA(0, 1, At, B1); PG8_BAR; PG8_SCHED;
            PG8_LDA(At, 1, 1); PG8_STAGE(PG8_SB(1, 0), b3, voffB); PG8_STAGE(PG8_SB(1, 1), b3 + hstepB, voffB1); PG8_STAGE(PG8_SA(1, 0), a3, sA[0]);
            PG8_WAIT_V(8); PG8_WAIT_L(0); PG8_BAR; PG8_MMA(1, 0, At, B0); PG8_MMA(1, 1, At, B1); PG8_BAR; PG8_SCHED;
#endif
            } else {
            PG8_LDB(B0, 0, 0); PG8_SCHED; PG8_LDA(At, 0, 0); PG8_STAGE(PG8_SA(1, 1), a1 + hstep, voffA);
            PG8_WAIT_L(8); PG8_BAR; PG8_WAIT_L(0); PG8_MMA(0, 0, At, B0); PG8_BAR; PG8_SCHED;
            PG8_LDB(B1, 0, 1); PG8_STAGE(PG8_SB(0, 0), b2, voffB);
            PG8_BAR; PG8_WAIT_L(0); PG8_MMA(0, 1, At, B1); PG8_BAR;
            PG8_LDA(At, 0, 1); PG8_STAGE(PG8_SA(0, 0), a2, voffA);
            PG8_BAR; PG8_WAIT_L(0); PG8_MMA(1, 0, At, B0); PG8_BAR; PG8_SCHED;
            PG8_STAGE(PG8_SB(0, 1), b2 + hstep, voffB);
            PG8_WAIT_V(6); PG8_BAR; PG8_MMA(1, 1, At, B1); PG8_BAR;
            PG8_LDB(B0, 1, 0); PG8_SCHED; PG8_LDA(At, 1, 0); PG8_STAGE(PG8_SA(0, 1), a2 + hstep, voffA);
            PG8_WAIT_L(8); PG8_BAR; PG8_WAIT_L(0); PG8_MMA(0, 0, At, B0); PG8_BAR; PG8_SCHED;
            PG8_LDB(B1, 1, 1); PG8_STAGE(PG8_SB(1, 0), b3, voffB);
            PG8_BAR; PG8_WAIT_L(0); PG8_MMA(0, 1, At, B1); PG8_BAR;
            PG8_LDA(At, 1, 1); PG8_STAGE(PG8_SA(1, 0), a3, voffA);
            PG8_BAR; PG8_WAIT_L(0); PG8_MMA(1, 0, At, B0); PG8_BAR; PG8_SCHED;
            PG8_STAGE(PG8_SB(1, 1), b3 + hstep, voffB);
            PG8_WAIT_V(6); PG8_BAR; PG8_MMA(1, 1, At, B1); PG8_BAR;
            }
#if defined(PROBE_KLOOP2)
            if (pass_end && !last) {
#pragma unroll
                for (int a_ = 0; a_ < 2; ++a_)
#pragma unroll
                    for (int b_ = 0; b_ < 2; ++b_)
#pragma unroll
                        for (int m_ = 0; m_ < 4; ++m_)
#pragma unroll
                            for (int n_ = 0; n_ < 2; ++n_) acc[a_][b_][m_][n_] = (f32x4){0.f, 0.f, 0.f, 0.f}; }
#endif
        }
        if constexpr (FP8) asm volatile("s_nop 15\n\ts_nop 7" ::: "memory");
        if constexpr (ALIGN_EPI) { if (wr == 0) PG8_BAR; }
        if constexpr (!Epi::AFTER_DRAIN) { int fr_e = fr, fq_e = fq; asm volatile("" : "+v"(fr_e), "+v"(fq_e));
            if constexpr (Epi::PREFETCH) E(acc, cur, wr, wc, fr_e, fq_e, ui & 1); else E(acc, cur, wr, wc, fr_e, fq_e);
#if defined(PROBE_EPI_TWICE)
            if constexpr (FP8 && !Epi::PREFETCH) { asm volatile("" : "+v"(fr_e), "+v"(fq_e)); E(acc, cur, wr, wc, fr_e, fq_e); }
#endif
            S.done(cur); }
        if (!has_next) break;
        if constexpr (!SP2)
#pragma unroll
        for (int a = 0; a < 2; ++a)
#pragma unroll
            for (int b = 0; b < 2; ++b)
#pragma unroll
                for (int m = 0; m < 4; ++m)
#pragma unroll
                    for (int n = 0; n < 2; ++n) acc[a][b][m][n] = (f32x4){0.f, 0.f, 0.f, 0.f};
        cur = nxt; cA = nA; cB = nB; ++ui;
        if constexpr (GATHER) {
#pragma unroll
            for (int h = 0; h < 2; ++h)
#pragma unroll
                for (int i = 0; i < 2; ++i) cvA[h][i] = nvA[h][i]; }
        if constexpr (ALIGN_EPI) { if (wr == 1) PG8_BAR; }
    }
    PG8_WAIT_V(0);
    S.flush();
    if constexpr (!ALIGN_EPI) { if (wr == 0) PG8_BAR; }
    PG8_BAR;
    if constexpr (Epi::AFTER_DRAIN) { E.fused(acc, cur, wr, wc, fr, fq, lds, wid, lane); S.done(cur); }
#undef PG8_SA
#undef PG8_SB
#undef PG8_STAGE
#undef PG8_LDA
#undef PG8_LDB
#undef PG8_MMA
#undef PG8_WAIT_V
#undef PG8_WAIT_L
#undef PG8_BAR
#undef PG8_SCHED
}
}

#define GAS __attribute__((address_space(1)))
#define LAS __attribute__((address_space(3)))
typedef unsigned short bf16;
typedef unsigned v4u __attribute__((ext_vector_type(4)));
typedef float f32x4 __attribute__((ext_vector_type(4)));
typedef short bf16x8 __attribute__((ext_vector_type(8)));
typedef GAS unsigned gu32;
typedef GAS unsigned long long gu64;
#define RLX_AGENT __ATOMIC_RELAXED, __HIP_MEMORY_SCOPE_AGENT
#define LDS_WAIT() asm volatile("s_waitcnt lgkmcnt(0)" ::: "memory")
#define VM_WAIT() asm volatile("s_waitcnt vmcnt(0)" ::: "memory")
__device__ __forceinline__ unsigned long long rt() { return __builtin_amdgcn_s_memrealtime(); }
__device__ __forceinline__ unsigned f2bf(float f) { unsigned u = __builtin_bit_cast(unsigned, f); return (u + 0x7fffu + ((u >> 16) & 1u)) >> 16; }
__device__ __forceinline__ unsigned pk2(float lo, float hi) { return f2bf(lo) | (f2bf(hi) << 16); }

#define XB_TMO      128
#define XB_XCNT(j)  (256  + 64 * (j))
#define XB_XSUB(j)  (1280 + 64 * (j))
#define XB_XGEN(j)  (2304 + 64 * (j))
#define XB_TOP      3328
#define XB_TOPGEN   3392
#define XCD_BAR_WORDS 3456
#define XB_SPIN_CAP (1u << 18)

__device__ __forceinline__ unsigned xb_ld(unsigned* p)              { return __hip_atomic_load(p, __ATOMIC_RELAXED, __HIP_MEMORY_SCOPE_AGENT); }
__device__ __forceinline__ unsigned xb_add(unsigned* p, unsigned v) { return __hip_atomic_fetch_add(p, v, __ATOMIC_RELAXED, __HIP_MEMORY_SCOPE_AGENT); }
__device__ __forceinline__ unsigned xb_xcc_id() { return (unsigned)__builtin_amdgcn_s_getreg((3 << 11) | 20) & 0xFu; }
#define XB_SPIN(cond, bar) do { unsigned _sp = 0; while (cond) { __builtin_amdgcn_s_sleep(1); \
    if ((++_sp & 255u) == 0u) { if (xb_ld(&(bar)[XB_TMO])) break; if (_sp > XB_SPIN_CAP) { atomicAdd(&(bar)[XB_TMO], 1u); break; } } } } while (0)

struct XcdBarrier {
    unsigned* bar; unsigned x;
    volatile LAS unsigned* st;
};

__device__ __forceinline__ XcdBarrier xcd_barrier_post(unsigned* bar, volatile LAS unsigned* st) {
    XcdBarrier b; b.bar = bar; b.x = xb_xcc_id(); b.st = st;
    if (threadIdx.x == 0) (void)xb_add(&bar[XB_XCNT(b.x)], 1u);
    return b;
}
__device__ __forceinline__ void xcd_barrier_complete(unsigned* bar, unsigned x, unsigned& nloc, unsigned& nx) {
    const unsigned G = gridDim.x * gridDim.y * gridDim.z;
    unsigned sum, cnt, mine, sp = 0u;
    for (;;) {
        sum = 0u; cnt = 0u; mine = 0u;
#pragma unroll
        for (unsigned j = 0; j < 16; ++j) { const unsigned c = xb_ld(&bar[XB_XCNT(j)]); sum += c; cnt += (c > 0u) ? 1u : 0u; mine = (j == x) ? c : mine; }
        if (sum == G) break;
        __builtin_amdgcn_s_sleep(1);
        if ((++sp & 255u) == 0u) { if (xb_ld(&bar[XB_TMO])) break; if (sp > XB_SPIN_CAP) { atomicAdd(&bar[XB_TMO], 1u); break; } }
    }
    nloc = mine > 0u ? mine : 1u; nx = cnt > 0u ? cnt : 1u;
}

__device__ __forceinline__ void xcd_barrier(const XcdBarrier& b) {
    asm volatile("s_waitcnt vmcnt(0)" ::: "memory");
    __syncthreads();
    if (threadIdx.x == 0) {
        unsigned* bar = b.bar;
        __builtin_amdgcn_s_waitcnt(0);
        unsigned nloc = b.st[0], nx = b.st[1];
        if (nloc == 0u) { xcd_barrier_complete(bar, b.x, nloc, nx); b.st[0] = nloc; b.st[1] = nx; }
        const unsigned old = xb_add(&bar[XB_XSUB(b.x)], 1u);
        const unsigned gen = old / nloc;
        if (old + 1u == (gen + 1u) * nloc) {
            __builtin_amdgcn_fence(__ATOMIC_RELEASE, "agent");
            asm volatile("s_waitcnt vmcnt(0)" ::: "memory");
            const unsigned og = xb_add(&bar[XB_TOP], 1u);
            const unsigned tg = og / nx;
            if (og + 1u == (tg + 1u) * nx) xb_add(&bar[XB_TOPGEN], 1u);
            else XB_SPIN(xb_ld(&bar[XB_TOPGEN]) == tg, bar);
            __builtin_amdgcn_fence(__ATOMIC_ACQUIRE, "agent");
            xb_add(&bar[XB_XGEN(b.x)], 1u);
            asm volatile("s_waitcnt vmcnt(0)" ::: "memory");
        } else {
            XB_SPIN(xb_ld(&bar[XB_XGEN(b.x)]) == gen, bar);
            __builtin_amdgcn_fence(__ATOMIC_ACQUIRE, "agent");
            asm volatile("s_waitcnt vmcnt(0)" ::: "memory");
        }
    }
    __syncthreads();
}

constexpr size_t MiB = 1u << 20;
constexpr size_t WS_CTL = 0, CTL_ZERO_BYTES = 160 * 1024;
constexpr size_t WS_MOD = 1 * MiB;
constexpr size_t WS_HIST = 2 * MiB;
constexpr size_t WS_META = 2 * MiB + 128 * 1024;
constexpr size_t WS_TOKE = 3 * MiB;
constexpr size_t WS_GATE = 3 * MiB + 512 * 1024;
constexpr size_t WS_RASG = 4 * MiB;
constexpr size_t WS_RGATE = 5 * MiB;
constexpr size_t WS_RWT = 7 * MiB;
constexpr size_t WS_RTOK = 6 * MiB;
constexpr size_t WS_W1T = 8 * MiB, WS_W2T = 12 * MiB, WS_KVT = 14 * MiB, WS_QT = 18 * MiB, WS_OT = 20 * MiB;
constexpr size_t WS_MIN = 24 * MiB;
constexpr size_t WS_MOUT = 280 * MiB;
constexpr size_t WS_RA = 408 * MiB;
constexpr size_t WS_RB = 680 * MiB;
constexpr size_t WS_S = 952 * MiB;
constexpr size_t WS_X = 1080 * MiB;
constexpr size_t WS_H2 = 1208 * MiB;
constexpr size_t WS_X2B = 1272 * MiB, WS_HQ = 1336 * MiB;
constexpr size_t WS_END = 1400 * MiB;
constexpr int CW_ADA = 64;
constexpr int CW_CNT = 8192, CNT_LAYER_WORDS = 16384;
static_assert((CW_CNT + 2 * CNT_LAYER_WORDS) * 4 <= (int)CTL_ZERO_BYTES && 16 * MAXRU <= CNT_LAYER_WORDS, "hand-off counters inside the per-call memset");
constexpr int CW_BAR = 4096;
static_assert((CW_BAR + 3456) * 4 <= (int)CTL_ZERO_BYTES, "barrier words inside the per-call memset");

constexpr int RING_OFF = 0, RING_BYTES = 131072;
constexpr int LDSCTL_OFF = RING_BYTES;
constexpr int LDS_BYTES = 147456;
constexpr int NWAVES = 8, NTHREADS = 512;

typedef float f32x16 __attribute__((ext_vector_type(16)));
#define CAS __attribute__((address_space(4)))
__device__ __forceinline__ const void* karg(unsigned byteoff) {
    asm volatile("" : "+s"(byteoff));
    const CAS char* kp = (const CAS char*)__builtin_amdgcn_kernarg_segment_ptr();
    const unsigned long long v = *(const CAS unsigned long long*)(kp + byteoff);
    return (const void*)(const __attribute__((address_space(1))) void*)v;
}
typedef pg8::f32x2_t f32x2_t;
typedef short s16x4 __attribute__((ext_vector_type(4)));
typedef unsigned u32x2 __attribute__((ext_vector_type(2)));

template <int CTRL> __device__ __forceinline__ float dppf(float v) { return __int_as_float(__builtin_amdgcn_update_dpp(0, __float_as_int(v), CTRL, 0xf, 0xf, false)); }
template <int CTRL> __device__ __forceinline__ int dppi(int v) { return __builtin_amdgcn_update_dpp(0, v, CTRL, 0xf, 0xf, false); }
__device__ __forceinline__ float wave_sum(float v) {
    v += dppf<0xB1>(v); v += dppf<0x4E>(v); v += dppf<0x141>(v); v += dppf<0x140>(v);
    const float s0 = __int_as_float(__builtin_amdgcn_readlane(__float_as_int(v), 0)), s1 = __int_as_float(__builtin_amdgcn_readlane(__float_as_int(v), 16));
    const float s2 = __int_as_float(__builtin_amdgcn_readlane(__float_as_int(v), 32)), s3 = __int_as_float(__builtin_amdgcn_readlane(__float_as_int(v), 48));
    return (s0 + s1) + (s2 + s3);
}
__device__ __forceinline__ float bf_lo(unsigned w) { return __uint_as_float(w << 16); }
__device__ __forceinline__ float bf_hi(unsigned w) { return __uint_as_float(w & 0xffff0000u); }
__device__ __forceinline__ unsigned pkbf(float lo, float hi) { return pg8::cvt_pk_bf16(lo, hi); }

__device__ __forceinline__ void p_ada(const float* c, const float* ada_w, const float* ada_b, float* mod, LAS unsigned char* lds, int vcu, int G, int tid, int wave, int lane) {
    LAS float* sc = (LAS float*)lds;
    LAS float* red = (LAS float*)(lds + 65536);
    constexpr int NC = 48, NJB = 6144 / NC;
    const int ln_c = lane < NC ? lane : NC - 1;
    for (int item = vcu; item < 2 * NJB; item += G) {
        const int l = item / NJB, jb = item % NJB;
        for (int idx = tid; idx < 16384; idx += NTHREADS) { const int b = idx >> 10, k = idx & 1023; const float v = c[idx]; sc[k * 16 + b] = v / (1.0f + __expf(-v)); }
        __syncthreads();
        float acc[16];
#pragma unroll
        for (int b = 0; b < 16; ++b) acc[b] = 0.f;
        const int k0 = wave * 128;
        const float* wp = ada_w + ((size_t)l * 1024 + k0) * 6144 + jb * NC + ln_c;
#pragma unroll 2
        for (int k64 = 0; k64 < 128; k64 += 64) { float wv64[64];
#pragma unroll
          for (int kk = 0; kk < 64; ++kk) wv64[kk] = wp[(size_t)(k64 + kk) * 6144];
#pragma unroll
          for (int k2 = 0; k2 < 64; ++k2) { const int kk = k64 + k2;
            const float wv = wv64[k2];
            const LAS f32x4* sp = (const LAS f32x4*)(sc + (k0 + kk) * 16);
#pragma unroll
            for (int q = 0; q < 4; ++q) { const f32x4 s4 = sp[q]; acc[4 * q] += s4[0] * wv; acc[4 * q + 1] += s4[1] * wv; acc[4 * q + 2] += s4[2] * wv; acc[4 * q + 3] += s4[3] * wv; }
          } }
#pragma unroll
        for (int b = 0; b < 16; ++b) red[(wave * 16 + b) * 64 + lane] = acc[b];
        __syncthreads();
        for (int idx = tid; idx < 1024; idx += NTHREADS) { const int b = idx >> 6, ln = idx & 63; float s = 0.f;
#pragma unroll
            for (int w = 0; w < 8; ++w) s += red[(w * 16 + b) * 64 + ln];
            if (ln < NC) mod[((size_t)l * 16 + b) * 6144 + jb * NC + ln] = s + ada_b[l * 6144 + jb * NC + ln]; }
        __syncthreads();
    }
}
__device__ __forceinline__ void transpose_item(const float* W, int K, int N, bf16* WT, bool glu, LAS float* scr, int item, int lane) {
    const int nblk = N / 32, kb = item / nblk, nb = item % nblk, k0 = 64 * kb, n0 = 32 * nb;
    const int r0 = glu ? (((n0 & 1023) >> 7) * 256 + (n0 >> 10) * 128 + (n0 & 127)) : n0;
#pragma unroll
    for (int i = 0; i < 32; ++i) { const int kk = 2 * i + (lane >> 5); scr[kk * 33 + (lane & 31)] = W[(size_t)(k0 + kk) * N + n0 + (lane & 31)]; }
    LDS_WAIT(); asm volatile("" ::: "memory");
    const int c = lane & 7;
#pragma unroll
    for (int j = 0; j < 4; ++j) { const int n = (lane >> 3) + 8 * j; const LAS float* s = scr + (8 * c) * 33 + n;
        v4u o; o.x = pkbf(s[0 * 33], s[1 * 33]); o.y = pkbf(s[2 * 33], s[3 * 33]); o.z = pkbf(s[4 * 33], s[5 * 33]); o.w = pkbf(s[6 * 33], s[7 * 33]);
        *(GAS v4u*)(WT + (size_t)(r0 + n) * K + k0 + 8 * c) = o; }
    LDS_WAIT(); asm volatile("" ::: "memory");
}
__device__ __forceinline__ void transpose_item_fp8(const float* W, int K, int N, unsigned char* WT8, bool glu, float scale, LAS float* scr, int item, int lane) {
    const int nblk = N / 32, kb = item / nblk, nb = item % nblk, k0 = 64 * kb, n0 = 32 * nb;
    const int r0 = glu ? (((n0 & 1023) >> 7) * 256 + (n0 >> 10) * 128 + (n0 & 127)) : n0;
#pragma unroll
    for (int i = 0; i < 32; ++i) { const int kk = 2 * i + (lane >> 5); scr[kk * 33 + (lane & 31)] = W[(size_t)(k0 + kk) * N + n0 + (lane & 31)]; }
    LDS_WAIT(); asm volatile("" ::: "memory");
    const int c = lane & 7;
#pragma unroll
    for (int j = 0; j < 4; ++j) { const int n = (lane >> 3) + 8 * j; const LAS float* s = scr + (8 * c) * 33 + n;
        u32x2 o; o.x = pg8::pk4_fp8(s[0 * 33] * scale, s[1 * 33] * scale, s[2 * 33] * scale, s[3 * 33] * scale); o.y = pg8::pk4_fp8(s[4 * 33] * scale, s[5 * 33] * scale, s[6 * 33] * scale, s[7 * 33] * scale);
        *(GAS u32x2*)(WT8 + (size_t)(r0 + n) * K + k0 + 8 * c) = o; }
    LDS_WAIT(); asm volatile("" ::: "memory");
}
#ifndef MOE_GATHER
#define MOE_GATHER 1
#endif
#ifndef MOE_FP8
#define MOE_FP8 1
#endif
constexpr float FP8_ACT_S = 4.0f, FP8_WIN_S = 32.0f, FP8_WOUT_S = 64.0f;
#ifndef DENSE8_QKV
#define DENSE8_QKV 1
#endif
#ifndef DENSE8_P2
#define DENSE8_P2 1
#endif
#ifndef DENSE8_P4
#define DENSE8_P4 1
#endif
#ifndef DENSE8_P12
#define DENSE8_P12 1
#endif
constexpr float DENSE8_W_S = 32.0f, DENSE8_A_S = 4.0f;
struct WPtrs { const float *w1, *w2, *kv, *q, *o, *min, *mout; bf16 *w1t, *w2t, *kvt, *qt, *ot, *mint, *moutt; };
struct CvtItem { const float* W; void* WT; int N; int k0, n0, r0; bool fp8, glu; float scale; };
#ifndef CVT_IN_CONV
#define CVT_IN_CONV 1
#endif
#ifndef CVT_WIDE
#define CVT_WIDE 1
#endif
template <int PART, bool WIDE = false> __device__ __forceinline__ bool cvt_item(const WPtrs& P, int it, CvtItem& I) {
    constexpr int I_W1 = 8 * 16, I_W2 = 8 * 8, I_KV = 8 * 16, I_Q = 8 * 8, I_O = 8 * 8, I_MIN = 8 * 16, I_MOUT = 8 * 8;
    constexpr int NM = (PART == 0 && !CVT_IN_CONV) ? 64 : 32, MI0 = PART == 0 ? 0 : 32;
    constexpr int NITEMS = (PART == 0 ? I_W1 + I_W2 + I_KV + I_Q + I_O : 0) + NM * I_MIN + NM * I_MOUT;
    if (it >= NITEMS) return false;
    int r = it; bool glu = false; I.fp8 = false; I.scale = 1.0f; size_t wt_elems = 0;
    if (r < NM * I_MIN) { const int mi = MI0 + r / I_MIN; r %= I_MIN; I.W = P.min + (size_t)mi * 1024 * 2048; I.N = 2048; glu = true; wt_elems = (size_t)mi * 2048 * 1024; I.WT = P.mint; I.fp8 = MOE_FP8; I.scale = MOE_FP8 ? FP8_WIN_S : 1.0f; }
    else { r -= NM * I_MIN;
      if (r < NM * I_MOUT) { const int mi = MI0 + r / I_MOUT; r %= I_MOUT; I.W = P.mout + (size_t)mi * 1024 * 1024; I.N = 1024; wt_elems = (size_t)mi * 1024 * 1024; I.WT = P.moutt; I.fp8 = MOE_FP8; I.scale = MOE_FP8 ? FP8_WOUT_S : 1.0f; }
      else { r -= NM * I_MOUT;
        if (r < I_W1) { I.W = P.w1; I.N = 2048; glu = true; I.WT = P.w1t; if (DENSE8_P2) { I.fp8 = true; I.scale = DENSE8_W_S; } }
        else { r -= I_W1; if (r < I_W2) { I.W = P.w2; I.N = 1024; I.WT = P.w2t; if (DENSE8_P4) { I.fp8 = true; I.scale = DENSE8_W_S; } }
          else { r -= I_W2; if (r < I_KV) { I.W = P.kv; I.N = 2048; I.WT = P.kvt; if (DENSE8_QKV) { I.fp8 = true; I.scale = DENSE8_W_S; } }
            else { r -= I_KV; if (r < I_Q) { I.W = P.q; I.N = 1024; I.WT = P.qt; if (DENSE8_QKV) { I.fp8 = true; I.scale = DENSE8_W_S; } } else { r -= I_Q; I.W = P.o; I.N = 1024; I.WT = P.ot; if (DENSE8_P12) { I.fp8 = true; I.scale = DENSE8_W_S; } } } } } } }
    if (WIDE) { const int nblk = I.N / 256, kb = r / nblk, nb = r % nblk; I.k0 = 64 * kb; I.n0 = 256 * nb; }
    else { const int nblk = I.N / 128, kb = r / nblk, nb = r % nblk; I.k0 = 128 * kb; I.n0 = 128 * nb; }
    I.r0 = glu ? (((I.n0 & 1023) >> 7) * 256 + (I.n0 >> 10) * 128) : I.n0;
    I.glu = glu;
    I.WT = (void*)((unsigned char*)I.WT + wt_elems * (I.fp8 ? 1 : 2));
    return true;
}
__device__ __forceinline__ void cvt_dma(const CvtItem& I, unsigned ldsbase  , int wave, int lane) {
    const unsigned rowb = (unsigned)I.N * 4u;
    const void* sb = (const void*)I.W;
#if CVT_WIDE
    const unsigned vb = (unsigned)(I.k0 + wave) * rowb + (unsigned)I.n0 * 4u + (unsigned)lane * 16u;
    pg8::glds16_i<0 * 8192>(vb + 0u * 8u * rowb, sb, ldsbase); pg8::glds16_i<1 * 8192>(vb + 1u * 8u * rowb, sb, ldsbase); pg8::glds16_i<2 * 8192>(vb + 2u * 8u * rowb, sb, ldsbase); pg8::glds16_i<3 * 8192>(vb + 3u * 8u * rowb, sb, ldsbase);
    pg8::glds16_i<4 * 8192>(vb + 4u * 8u * rowb, sb, ldsbase); pg8::glds16_i<5 * 8192>(vb + 5u * 8u * rowb, sb, ldsbase); pg8::glds16_i<6 * 8192>(vb + 6u * 8u * rowb, sb, ldsbase); pg8::glds16_i<7 * 8192>(vb + 7u * 8u * rowb, sb, ldsbase);
#else
    const unsigned p = (unsigned)(lane & 31);
    const unsigned vb = (unsigned)(I.k0 + 2 * wave + (lane >> 5)) * rowb + (unsigned)I.n0 * 4u;
    pg8::glds16_i<0 * 8192>(vb + 0u * 16u * rowb + ((p ^ 0u) << 4), sb, ldsbase);  pg8::glds16_i<1 * 8192>(vb + 1u * 16u * rowb + ((p ^ 0u) << 4), sb, ldsbase);
    pg8::glds16_i<2 * 8192>(vb + 2u * 16u * rowb + ((p ^ 4u) << 4), sb, ldsbase);  pg8::glds16_i<3 * 8192>(vb + 3u * 16u * rowb + ((p ^ 4u) << 4), sb, ldsbase);
    pg8::glds16_i<4 * 8192>(vb + 4u * 16u * rowb + ((p ^ 8u) << 4), sb, ldsbase);  pg8::glds16_i<5 * 8192>(vb + 5u * 16u * rowb + ((p ^ 8u) << 4), sb, ldsbase);
    pg8::glds16_i<6 * 8192>(vb + 6u * 16u * rowb + ((p ^ 12u) << 4), sb, ldsbase); pg8::glds16_i<7 * 8192>(vb + 7u * 16u * rowb + ((p ^ 12u) << 4), sb, ldsbase);
#endif
}
__device__ __forceinline__ void cvt_tile_out(const CvtItem& I, const LAS unsigned char* tile, int tid) {
#if CVT_WIDE
    const int sn = tid >> 1, skq = tid & 1;
    const LAS float* tp = (const LAS float*)(tile + (unsigned)(32 * skq) * 1024u + (unsigned)(sn << 2));
    constexpr int JS = 256;
    const int orow = I.r0 + (sn & 127) + (sn >> 7) * (I.glu ? 256 : 128);
#else
    const int sn = tid >> 2, skq = tid & 3;
    const LAS float* tp = (const LAS float*)(tile + (unsigned)(32 * skq) * 512u + (unsigned)((((sn >> 2) ^ (skq << 2)) << 4) + ((sn & 3) << 2)));
    constexpr int JS = 128;
    const int orow = I.r0 + sn;
#endif
    float v[32];
#pragma unroll
    for (int j = 0; j < 32; ++j) v[j] = tp[j * JS] * I.scale;
    v4u o0, o1;
    o0.x = pg8::pk4_fp8(v[0], v[1], v[2], v[3]); o0.y = pg8::pk4_fp8(v[4], v[5], v[6], v[7]); o0.z = pg8::pk4_fp8(v[8], v[9], v[10], v[11]); o0.w = pg8::pk4_fp8(v[12], v[13], v[14], v[15]);
    o1.x = pg8::pk4_fp8(v[16], v[17], v[18], v[19]); o1.y = pg8::pk4_fp8(v[20], v[21], v[22], v[23]); o1.z = pg8::pk4_fp8(v[24], v[25], v[26], v[27]); o1.w = pg8::pk4_fp8(v[28], v[29], v[30], v[31]);
    unsigned char* op = (unsigned char*)I.WT + (size_t)orow * 1024 + I.k0 + 32 * skq;
    pg8::st16(op, o0); pg8::st16(op + 16, o1);
}
__device__ __forceinline__ void p_convert(const WPtrs& P, LAS unsigned char* lds, int vcu, int G, int tid) {
#if CVT_WIDE
    constexpr int PT = 260;
    LAS float* tile = (LAS float*)lds;
    const int lr = tid >> 6, lc = tid & 63;
    const int sn = tid >> 1, skq = tid & 1;
    constexpr int RS = 8;
#else
    constexpr int PT = 132;
    LAS float* tile = (LAS float*)lds;
    const int lr = tid >> 5, lc = tid & 31;
    const int sn = tid >> 2, skq = tid & 3;
    constexpr int RS = 16;
#endif
    CvtItem cur, nxt; f32x4 reg[8];
    bool have = cvt_item<0, CVT_WIDE != 0>(P, vcu, cur);
    if (have) {
#pragma unroll
        for (int i = 0; i < 8; ++i) reg[i] = *(const f32x4*)(cur.W + (size_t)(cur.k0 + lr + RS * i) * cur.N + cur.n0 + 4 * lc); }
    for (int it = vcu; have; it += G) {
        __syncthreads();
#pragma unroll
        for (int i = 0; i < 8; ++i) *(LAS f32x4*)(tile + (lr + RS * i) * PT + 4 * lc) = reg[i];
        __syncthreads();
        const bool hn = cvt_item<0, CVT_WIDE != 0>(P, it + G, nxt);
        if (hn) {
#pragma unroll
            for (int i = 0; i < 8; ++i) reg[i] = *(const f32x4*)(nxt.W + (size_t)(nxt.k0 + lr + RS * i) * nxt.N + nxt.n0 + 4 * lc); }
        float v[32];
#pragma unroll
        for (int j = 0; j < 32; ++j) v[j] = tile[(32 * skq + j) * PT + sn] * cur.scale;
        const int orow = CVT_WIDE ? cur.r0 + (sn & 127) + (sn >> 7) * (cur.glu ? 256 : 128) : cur.r0 + sn;
        if (cur.fp8) { v4u o0, o1;
            o0.x = pg8::pk4_fp8(v[0], v[1], v[2], v[3]); o0.y = pg8::pk4_fp8(v[4], v[5], v[6], v[7]); o0.z = pg8::pk4_fp8(v[8], v[9], v[10], v[11]); o0.w = pg8::pk4_fp8(v[12], v[13], v[14], v[15]);
            o1.x = pg8::pk4_fp8(v[16], v[17], v[18], v[19]); o1.y = pg8::pk4_fp8(v[20], v[21], v[22], v[23]); o1.z = pg8::pk4_fp8(v[24], v[25], v[26], v[27]); o1.w = pg8::pk4_fp8(v[28], v[29], v[30], v[31]);
            unsigned char* op = (unsigned char*)cur.WT + (size_t)orow * 1024 + cur.k0 + 32 * skq;
            pg8::st16(op, o0); pg8::st16(op + 16, o1);
        } else { bf16* op = (bf16*)cur.WT + (size_t)orow * 1024 + cur.k0 + 32 * skq;
#pragma unroll
            for (int q = 0; q < 4; ++q) { v4u o; o.x = pkbf(v[8 * q], v[8 * q + 1]); o.y = pkbf(v[8 * q + 2], v[8 * q + 3]); o.z = pkbf(v[8 * q + 4], v[8 * q + 5]); o.w = pkbf(v[8 * q + 6], v[8 * q + 7]);
                pg8::st16(op + 8 * q, o); } }
        cur = nxt; have = hn;
    }
    __syncthreads();
}
__device__ __forceinline__ void p_modulate(const float* x, const float* modl, bf16* hA, int vcu, int G, int wave, int lane) {
    const int gw = vcu * NWAVES + wave, NGW = G * NWAVES, RPW = (T + NGW - 1) / NGW;
    const int m0 = gw * RPW, m1 = (m0 + RPW) < T ? (m0 + RPW) : T;
    if (m0 < m1) {
    f32x4 nx[4];
#pragma unroll
    for (int j = 0; j < 4; ++j) nx[j] = *(const f32x4*)(x + (size_t)m0 * D + 256 * j + 4 * lane);
    f32x4 SC[4], SH[4]; int bcur = -1;
    for (int m = m0; m < m1; ++m) {
        const int b = m >> 11;
        if (b != bcur) { bcur = b; const float* sh = modl + (size_t)b * 6144; const float* sc = sh + 1024;
#pragma unroll
            for (int j = 0; j < 4; ++j) { const int c = 256 * j + 4 * lane; SC[j] = *(const f32x4*)(sc + c) + 1.0f; SH[j] = *(const f32x4*)(sh + c); } }
        f32x4 v[4];
#pragma unroll
        for (int j = 0; j < 4; ++j) v[j] = nx[j];
        if (m + 1 < m1) {
#pragma unroll
            for (int j = 0; j < 4; ++j) nx[j] = *(const f32x4*)(x + (size_t)(m + 1) * D + 256 * j + 4 * lane); }
#pragma unroll
        for (int j = 0; j < 4; ++j) { const int c = 256 * j + 4 * lane;
            const f32x4 h = v[j] * SC[j] + SH[j];
#if DENSE8_P2
            pg8::st4((unsigned char*)hA + (size_t)m * D + c, pg8::pk4_fp8(h[0] * DENSE8_A_S, h[1] * DENSE8_A_S, h[2] * DENSE8_A_S, h[3] * DENSE8_A_S)); }
#else
            u32x2 w; w.x = pkbf(h[0], h[1]); w.y = pkbf(h[2], h[3]); pg8::st8(hA + (size_t)m * D + c, w); }
#endif
    }
    }
}
__device__ __forceinline__ void p_conv(const bf16* glu, const float* dw, const float* db, const float* lg, const float* lb, bf16* u2, LAS unsigned char* lds, int vcu, int G, int tid, int wave, int lane, const WPtrs& P) {
    const int c0 = 2 * tid;
    f32x2_t wt[CONVW];
#pragma unroll
    for (int w = 0; w < CONVW; ++w) wt[w] = *(const f32x2_t*)(dw + w * D + c0);
    const f32x2_t dbv = *(const f32x2_t*)(db + c0), lgv = *(const f32x2_t*)(lg + c0), lbv = *(const f32x2_t*)(lb + c0);
#if CVT_IN_CONV && MOE_FP8
    LAS float* red = (LAS float*)(lds + LDSCTL_OFF + 4096);
    int cvt_next = vcu; CvtItem ccur, cnxt; int cpar = 0;
    const unsigned cv_lds = (unsigned)__builtin_amdgcn_readfirstlane((int)((unsigned)(size_t)lds + (unsigned)wave * 1024u));
    bool chc = cvt_item<1, CVT_WIDE != 0>(P, cvt_next, ccur);
    if (chc) cvt_dma(ccur, cv_lds, wave, lane);
#else
    LAS float* red = (LAS float*)lds;
#endif
    constexpr int TB = 8, NWIN = TB + CONVW - 1;
    constexpr int NU = T / TB, UPB = SEQ / TB;
    unsigned wn[NWIN];
    if (vcu < NU) { const int u = vcu; const int b = u / UPB, t0 = (u % UPB) * TB; const bf16* rowp = glu + ((ptrdiff_t)(b * SEQ + t0) - (CONVW - 1)) * D + c0;
#pragma unroll
      for (int j = 0; j < NWIN; ++j) wn[j] = *(const unsigned*)(rowp + (ptrdiff_t)j * D); }
    for (int u = vcu; u < NU; u += G) {
        const int b = u / UPB, t0 = (u % UPB) * TB;
        f32x2_t win[NWIN];
#pragma unroll
        for (int j = 0; j < NWIN; ++j) win[j] = (f32x2_t){bf_lo(wn[j]), bf_hi(wn[j])};
        if (t0 < CONVW - 1) {
#pragma unroll
            for (int j = 0; j < NWIN; ++j) if (t0 - (CONVW - 1) + j < 0) win[j] = (f32x2_t){0.f, 0.f}; }
        { const int un = u + G; const int bn = un / UPB, tn = (un % UPB) * TB;
          if (un < NU) { const bf16* rowp = glu + ((ptrdiff_t)(bn * SEQ + tn) - (CONVW - 1)) * D + c0;
#pragma unroll
              for (int j = 0; j < NWIN; ++j) wn[j] = *(const unsigned*)(rowp + (ptrdiff_t)j * D); } }
#if CVT_IN_CONV && MOE_FP8
        bool chn = false;
        if (chc) { chn = cvt_item<1, CVT_WIDE != 0>(P, cvt_next + G, cnxt); if (chn) cvt_dma(cnxt, cv_lds + (unsigned)(cpar ^ 1) * 65536u, wave, lane); }
#endif
        f32x2_t o[TB]; float st[2 * TB];
#pragma unroll
        for (int i = 0; i < TB; ++i) { f32x2_t a = dbv;
#pragma unroll
            for (int w = 0; w < CONVW; ++w) a = win[i + w] * wt[w] + a;
            o[i] = a; st[i] = a.x + a.y; st[TB + i] = a.x * a.x + a.y * a.y; }
        float a8[8], a4[4], a2[2], a1;
#pragma unroll
        for (int k = 0; k < 8; ++k) { const auto sw2 = __builtin_amdgcn_permlane32_swap(__float_as_uint(st[k]), __float_as_uint(st[k + 8]), false, false); a8[k] = __uint_as_float(sw2[0]) + __uint_as_float(sw2[1]); }
#pragma unroll
        for (int k = 0; k < 4; ++k) { const auto sw2 = __builtin_amdgcn_permlane16_swap(__float_as_uint(a8[k]), __float_as_uint(a8[k + 4]), false, false); a4[k] = __uint_as_float(sw2[0]) + __uint_as_float(sw2[1]); }
        { const bool up = (lane & 8) != 0;
#pragma unroll
          for (int k = 0; k < 2; ++k) { const float keep = up ? a4[k + 2] : a4[k], send = up ? a4[k] : a4[k + 2]; a2[k] = keep + dppf<0x140>(send); } }
        { const bool up = (lane & 4) != 0; const float keep = up ? a2[1] : a2[0], send = up ? a2[0] : a2[1]; a1 = keep + dppf<0x141>(send); }
        a1 += dppf<0x4E>(a1); a1 += dppf<0xB1>(a1);
        if ((lane & 3) == 0) red[wave * 16 + (lane >> 2)] = a1;
#if CVT_IN_CONV && MOE_FP8
        if (chn) asm volatile("s_waitcnt vmcnt(8)" ::: "memory"); else asm volatile("s_waitcnt vmcnt(0)" ::: "memory");
#endif
        __syncthreads();
        float tot = 0.f;
        if (lane < 16) {
#pragma unroll
            for (int w = 0; w < 8; ++w) tot += red[w * 16 + lane]; }
        const float totq = __shfl(tot, (lane + 8) & 63);
        const float mean_l = tot * (1.0f / D), rstd_l = 1.0f / sqrtf(fmaxf(totq * (1.0f / D) - mean_l * mean_l, 0.f) + LN_EPS);
#pragma unroll
        for (int i = 0; i < TB; ++i) { const float mean = __int_as_float(__builtin_amdgcn_readlane(__float_as_int(mean_l), i)), rstd = __int_as_float(__builtin_amdgcn_readlane(__float_as_int(rstd_l), i));
            const f32x2_t rg = lgv * rstd, cc = lbv - rg * mean, yv = o[i] * rg + cc;
            float y0 = yv.x, y1 = yv.y;
            y0 = y0 * pg8::sigmoidf_(y0); y1 = y1 * pg8::sigmoidf_(y1);
#if DENSE8_P4
            { unsigned w8 = 0u; w8 = __builtin_amdgcn_cvt_pk_fp8_f32(pg8::clamp448(y0 * DENSE8_A_S), pg8::clamp448(y1 * DENSE8_A_S), w8, false);
              pg8::st2((unsigned char*)u2 + ((size_t)(b * SEQ + t0 + i)) * D + c0, (unsigned short)w8); } }
#else
            pg8::st4(u2 + ((size_t)(b * SEQ + t0 + i)) * D + c0, pkbf(y0, y1)); }
#endif
#if CVT_IN_CONV && MOE_FP8
        if (chc) cvt_tile_out(ccur, lds + cpar * 65536, tid);
        ccur = cnxt; chc = chn; cpar ^= 1; cvt_next += G;
#endif
        __syncthreads();
    }
#if CVT_IN_CONV && MOE_FP8
    while (chc) {
        bool chn = cvt_item<1, CVT_WIDE != 0>(P, cvt_next + G, cnxt); if (chn) cvt_dma(cnxt, cv_lds + (unsigned)(cpar ^ 1) * 65536u, wave, lane);
        if (chn) asm volatile("s_waitcnt vmcnt(8)" ::: "memory"); else asm volatile("s_waitcnt vmcnt(0)" ::: "memory");
        __syncthreads();
        cvt_tile_out(ccur, lds + cpar * 65536, tid);
        ccur = cnxt; chc = chn; cpar ^= 1; cvt_next += G;
        __syncthreads();
    }
#endif
}
__device__ __forceinline__ void p_router(const bf16* S, const float* lng, const float* lnb, const float* modl, const float* rw, const float* rb, bf16* X, bf16* H2,
                                         int* tok_e, float* gates, int* wg_hist, LAS unsigned char* lds, LAS unsigned* hist, int vcu, int G, int tid, int wave, int lane) {
    for (int idx = tid; idx < 8192; idx += NTHREADS) { const int c = idx >> 3, g = idx & 7; const f32x4 v = *(const f32x4*)(rw + c * 32 + 4 * g);
        *(LAS f32x4*)(lds + c * 128 + ((g ^ ((c >> 2) & 7)) << 4)) = v; }
    if (tid < 32) hist[tid] = 0u;
    __syncthreads();
    const int gw = vcu * NWAVES + wave, NGW = G * NWAVES;
    const int tt_me = lane >> 4, sub = (lane >> 2) & 3;
    u32x2 pre[4][4];
    if (gw < T / 4) {
#pragma unroll
        for (int tt = 0; tt < 4; ++tt)
#pragma unroll
            for (int j = 0; j < 4; ++j) pre[tt][j] = *(const u32x2*)(S + (size_t)(gw * 4 + tt) * D + 256 * j + 4 * lane); }
    for (int grp = gw; grp < T / 4; grp += NGW) {
        const int m0 = grp * 4, b = m0 >> 11;
        const float* sh2 = modl + (size_t)b * 6144 + 3 * 1024; const float* sc2 = sh2 + 1024;
        float hv[4][16];
#pragma unroll
        for (int tt = 0; tt < 4; ++tt) { const int m = m0 + tt;
            f32x4 v[4]; float s = 0.f;
#pragma unroll
            for (int j = 0; j < 4; ++j) { const u32x2 w = pre[tt][j]; v[j] = (f32x4){bf_lo(w.x), bf_hi(w.x), bf_lo(w.y), bf_hi(w.y)}; s += (v[j][0] + v[j][1]) + (v[j][2] + v[j][3]); }
            const float mean = wave_sum(s) * (1.0f / D); float q = 0.f;
#pragma unroll
            for (int j = 0; j < 4; ++j) { v[j] = v[j] - mean; q += (v[j][0] * v[j][0] + v[j][1] * v[j][1]) + (v[j][2] * v[j][2] + v[j][3] * v[j][3]); }
            const float rstd = 1.0f / sqrtf(wave_sum(q) * (1.0f / D) + LN_EPS);
#pragma unroll
            for (int j = 0; j < 4; ++j) { const int c = 256 * j + 4 * lane;
                const f32x4 x1 = v[j] * rstd * *(const f32x4*)(lng + c) + *(const f32x4*)(lnb + c);
                { u32x2 w; w.x = pkbf(x1[0], x1[1]); w.y = pkbf(x1[2], x1[3]); pg8::st8(X + (size_t)m * D + c, w); }
                const f32x4 h = x1 * (*(const f32x4*)(sc2 + c) + 1.0f) + *(const f32x4*)(sh2 + c);
#if MOE_FP8
                pg8::st4((unsigned char*)H2 + (size_t)m * D + c, pg8::pk4_fp8(h[0] * FP8_ACT_S, h[1] * FP8_ACT_S, h[2] * FP8_ACT_S, h[3] * FP8_ACT_S));
#else
                u32x2 w; w.x = pkbf(h[0], h[1]); w.y = pkbf(h[2], h[3]); *(u32x2*)(H2 + (size_t)m * D + c) = w;
#endif
                hv[tt][4 * j] = h[0]; hv[tt][4 * j + 1] = h[1]; hv[tt][4 * j + 2] = h[2]; hv[tt][4 * j + 3] = h[3]; }
            asm volatile("" ::: "memory");
        }
        if (grp + NGW < T / 4) {
#pragma unroll
            for (int tt = 0; tt < 4; ++tt)
#pragma unroll
                for (int j = 0; j < 4; ++j) pre[tt][j] = *(const u32x2*)(S + (size_t)((grp + NGW) * 4 + tt) * D + 256 * j + 4 * lane); }
        float lg[8];
#pragma unroll
        for (int g = 0; g < 8; ++g) lg[g] = 0.f;
#pragma unroll 2
        for (int g = 0; g < 8; ++g) {
            f32x2_t p2[8];
#pragma unroll
            for (int k = 0; k < 8; ++k) p2[k] = (f32x2_t){0.f, 0.f};
            const int sw = (g ^ (lane & 7)) << 4;
#pragma unroll
            for (int j = 0; j < 4; ++j)
#pragma unroll
                for (int i = 0; i < 4; ++i) { const int c = 256 * j + 4 * lane + i;
                    const f32x4 w4 = *(const LAS f32x4*)(lds + c * 128 + sw); const f32x2_t wlo = {w4[0], w4[1]}, whi = {w4[2], w4[3]};
#pragma unroll
                    for (int tt = 0; tt < 4; ++tt) { const float hx = hv[tt][4 * j + i]; const f32x2_t hh = {hx, hx}; p2[tt * 2] = hh * wlo + p2[tt * 2]; p2[tt * 2 + 1] = hh * whi + p2[tt * 2 + 1]; } }
            float p[16];
#pragma unroll
            for (int k = 0; k < 8; ++k) { p[2 * k] = p2[k].x; p[2 * k + 1] = p2[k].y; }
            float a8[8], a4[4], a2[2], a1;
#pragma unroll
            for (int k = 0; k < 8; ++k) { const auto sw2 = __builtin_amdgcn_permlane32_swap(__float_as_uint(p[k]), __float_as_uint(p[k + 8]), false, false); a8[k] = __uint_as_float(sw2[0]) + __uint_as_float(sw2[1]); }
#pragma unroll
            for (int k = 0; k < 4; ++k) { const auto sw2 = __builtin_amdgcn_permlane16_swap(__float_as_uint(a8[k]), __float_as_uint(a8[k + 4]), false, false); a4[k] = __uint_as_float(sw2[0]) + __uint_as_float(sw2[1]); }
            { const bool up = (lane & 8) != 0;
#pragma unroll
              for (int k = 0; k < 2; ++k) { const float keep = up ? a4[k + 2] : a4[k], send = up ? a4[k] : a4[k + 2]; a2[k] = keep + dppf<0x140>(send); } }
            { const bool up = (lane & 4) != 0; const float keep = up ? a2[1] : a2[0], send = up ? a2[0] : a2[1]; a1 = keep + dppf<0x141>(send); }
            a1 += dppf<0x4E>(a1); a1 += dppf<0xB1>(a1);
            a1 += rb[4 * g + sub];
#pragma unroll
            for (int gg = 0; gg < 8; ++gg) lg[gg] = (gg == g) ? a1 : lg[gg];
        }
        float tv[4]; int te[4];
#pragma unroll
        for (int k = 0; k < 4; ++k) {
            float bv = lg[0]; int be = sub;
#pragma unroll
            for (int g = 1; g < 8; ++g) { const bool better = lg[g] > bv; bv = better ? lg[g] : bv; be = better ? 4 * g + sub : be; }
            { const float ov = dppf<0x141>(bv); const int oe = dppi<0x141>(be); const bool better = (ov > bv) || (ov == bv && oe < be); bv = better ? ov : bv; be = better ? oe : be; }
            { const float ov = dppf<0x140>(bv); const int oe = dppi<0x140>(be); const bool better = (ov > bv) || (ov == bv && oe < be); bv = better ? ov : bv; be = better ? oe : be; }
            tv[k] = bv; te[k] = be;
#pragma unroll
            for (int g = 0; g < 8; ++g) lg[g] = (4 * g + sub == be) ? -INFINITY : lg[g];
        }
        const float e1 = __expf(tv[1] - tv[0]), e2 = __expf(tv[2] - tv[0]), e3 = __expf(tv[3] - tv[0]), inv = 1.0f / (1.0f + e1 + e2 + e3);
        const int kk = lane & 15;
        if (kk < 4) { const int e = kk == 0 ? te[0] : kk == 1 ? te[1] : kk == 2 ? te[2] : te[3]; const float gt = (kk == 0 ? 1.0f : kk == 1 ? e1 : kk == 2 ? e2 : e3) * inv;
            const unsigned lpos = atomicAdd((unsigned*)(hist + e), 1u);
            const int a = (m0 + tt_me) * 4 + kk; tok_e[a] = e | (int)(lpos << 8); gates[a] = gt; }
    }
    __syncthreads();
    if (tid < 32) wg_hist[vcu * 32 + tid] = (int)hist[tid];
}
#ifndef FINAL_FROM_S
#define FINAL_FROM_S 1
#endif
#ifndef ROUTER_MFMA
#define ROUTER_MFMA 1
#endif
__device__ __forceinline__ void p_rwt(const float* router_w, bf16* rwt, int vcu, int G, int tid) {
    for (int idx = vcu * NTHREADS + tid; idx < 2 * NE * D; idx += G * NTHREADS) { const int l = idx >> 15, e = (idx >> 10) & 31, ch = idx & 1023;
        const float w = router_w[((size_t)l * D + ch) * NE + e]; const unsigned hi = pkbf(w, 0.f) & 0xffffu; const float r = w - __uint_as_float(hi << 16);
        rwt[((size_t)(l * 2 + 0) * NE + e) * D + ch] = (bf16)hi; rwt[((size_t)(l * 2 + 1) * NE + e) * D + ch] = (bf16)(pkbf(r, 0.f) & 0xffffu); }
}
__device__ __forceinline__ void best2(float& bv, int& be, float ov, int oe) { const bool better = (ov > bv) || (ov == bv && oe < be); bv = better ? ov : bv; be = better ? oe : be; }
__device__ __forceinline__ void p_router_mfma(const bf16* S, const float* lng, const float* lnb, const float* modl, const bf16* rwt, const float* rb, bf16* X, bf16* H2,
                                              int* tok_e, float* gates, int* wg_hist, LAS unsigned char* lds, LAS unsigned* hist, int vcu, int G, int tid, int wave, int lane) {
    { v4u wv[16];
#pragma unroll
      for (int q = 0; q < 16; ++q) wv[q] = *(const v4u*)(rwt + (size_t)(tid + q * NTHREADS) * 8);
#pragma unroll
      for (int q = 0; q < 16; ++q) { const int idx = tid + q * NTHREADS, p = idx >> 12, e = (idx >> 7) & 31, ch = idx & 127; *(LAS v4u*)(lds + p * 65536 + e * 2048 + ((ch ^ (e & 15)) << 4)) = wv[q]; } }
    if (tid < 32) hist[tid] = 0u;
    __syncthreads();
    const int gw = vcu * NWAVES + wave, NGW = G * NWAVES, tk = lane & 15, kg = lane >> 4;
    static_assert(FINAL_FROM_S != 0, "the folded form does not produce x1");
    LAS float* gcb = (LAS float*)(lds + LDSCTL_OFF + 4096);
    int bcur = -1;
    for (int task = gw; task < T / 16; task += NGW) {
        const int m = task * 16 + tk, b = (task * 16) >> 11; const bf16* Sp = S + (size_t)m * D + 8 * kg; unsigned char* Hp = (unsigned char*)H2 + (size_t)m * (MOE_FP8 ? D : 2 * D) + (MOE_FP8 ? 8 : 16) * kg;
        v4u raw[2][8];
#pragma unroll
        for (int s = 0; s < 8; ++s) raw[0][s] = *(const v4u*)(Sp + 32 * s);
        if (b != bcur) { bcur = b; __syncthreads();
            { const int c = 2 * tid; const float* sh2 = modl + (size_t)b * 6144 + 3 * 1024; const float* sc2 = sh2 + 1024;
              const f32x2_t g2 = *(const f32x2_t*)(lng + c), b2 = *(const f32x2_t*)(lnb + c), s2 = *(const f32x2_t*)(sc2 + c) + 1.0f, h2 = *(const f32x2_t*)(sh2 + c);
              *(LAS f32x2_t*)(gcb + c) = g2 * s2; *(LAS f32x2_t*)(gcb + 1024 + c) = b2 * s2 + h2; }
            __syncthreads(); }
        float sum = 0.f, sq = 0.f;
#pragma unroll
        for (int g = 0; g < 4; ++g) {
            if (g < 3) {
#pragma unroll
                for (int s = 0; s < 8; ++s) raw[(g + 1) & 1][s] = *(const v4u*)(Sp + 32 * (8 * (g + 1) + s)); }
            else {
#pragma unroll
                for (int s = 0; s < 8; ++s) raw[(g + 1) & 1][s] = *(const v4u*)(Sp + 32 * s); }
#pragma unroll
            for (int s = 0; s < 8; ++s) { const v4u w = raw[g & 1][s]; const float d0 = bf_lo(w.x), d1 = bf_hi(w.x), d2 = bf_lo(w.y), d3 = bf_hi(w.y), d4 = bf_lo(w.z), d5 = bf_hi(w.z), d6 = bf_lo(w.w), d7 = bf_hi(w.w);
                sum += ((d0 + d1) + (d2 + d3)) + ((d4 + d5) + (d6 + d7)); sq += ((d0 * d0 + d1 * d1) + (d2 * d2 + d3 * d3)) + ((d4 * d4 + d5 * d5) + (d6 * d6 + d7 * d7)); }
            asm volatile("" ::: "memory"); }
        sum += __shfl_xor(sum, 16); sum += __shfl_xor(sum, 32); sq += __shfl_xor(sq, 16); sq += __shfl_xor(sq, 32);
        const float mean = sum * (1.0f / D); const float rstd = 1.0f / sqrtf(fmaxf(sq * (1.0f / D) - mean * mean, 0.f) + LN_EPS);
        const float nmr = -mean * rstd;
        f32x4 acc0 = {0.f, 0.f, 0.f, 0.f}, acc1 = {0.f, 0.f, 0.f, 0.f};
        const LAS unsigned char* wrow = lds + (lane & 15) * 2048;
        const LAS float* gl = gcb + 8 * kg;
#pragma unroll
        for (int g = 0; g < 4; ++g) {
            if (g < 3) {
#pragma unroll
                for (int s = 0; s < 8; ++s) raw[(g + 1) & 1][s] = *(const v4u*)(Sp + 32 * (8 * (g + 1) + s)); }
#pragma unroll
            for (int s8 = 0; s8 < 8; ++s8) { const int s = 8 * g + s8; const v4u w = raw[g & 1][s8];
                const float xv[8] = {bf_lo(w.x), bf_hi(w.x), bf_lo(w.y), bf_hi(w.y), bf_lo(w.z), bf_hi(w.z), bf_lo(w.w), bf_hi(w.w)};
                float hh[8];
#pragma unroll
                for (int hq4 = 0; hq4 < 2; ++hq4) { const f32x4 g4 = *(const LAS f32x4*)(gl + 32 * s + 4 * hq4), b4 = *(const LAS f32x4*)(gl + 1024 + 32 * s + 4 * hq4);
#pragma unroll
                    for (int i = 0; i < 4; ++i) hh[4 * hq4 + i] = (xv[4 * hq4 + i] * rstd + nmr) * g4[i] + b4[i]; }
#if MOE_FP8
                { u32x2 o; o.x = pg8::pk4_fp8(hh[0] * FP8_ACT_S, hh[1] * FP8_ACT_S, hh[2] * FP8_ACT_S, hh[3] * FP8_ACT_S); o.y = pg8::pk4_fp8(hh[4] * FP8_ACT_S, hh[5] * FP8_ACT_S, hh[6] * FP8_ACT_S, hh[7] * FP8_ACT_S);
                  pg8::st8(Hp + 32 * s, o); }
#else
                { v4u o; o.x = pkbf(hh[0], hh[1]); o.y = pkbf(hh[2], hh[3]); o.z = pkbf(hh[4], hh[5]); o.w = pkbf(hh[6], hh[7]); *(v4u*)(Hp + 64 * s) = o; }
#endif
                v4u hi, lo;
                hi.x = pkbf(hh[0], hh[1]); hi.y = pkbf(hh[2], hh[3]); hi.z = pkbf(hh[4], hh[5]); hi.w = pkbf(hh[6], hh[7]);
                lo.x = pkbf(hh[0] - bf_lo(hi.x), hh[1] - bf_hi(hi.x)); lo.y = pkbf(hh[2] - bf_lo(hi.y), hh[3] - bf_hi(hi.y)); lo.z = pkbf(hh[4] - bf_lo(hi.z), hh[5] - bf_hi(hi.z)); lo.w = pkbf(hh[6] - bf_lo(hi.w), hh[7] - bf_hi(hi.w));
                const bf16x8 bhi = __builtin_bit_cast(bf16x8, hi), blo = __builtin_bit_cast(bf16x8, lo);
                const int swz = ((4 * s + kg) ^ (lane & 15)) << 4;
                const bf16x8 a0h = *(const LAS bf16x8*)(wrow + swz), a1h = *(const LAS bf16x8*)(wrow + 16 * 2048 + swz), a0l = *(const LAS bf16x8*)(wrow + 65536 + swz), a1l = *(const LAS bf16x8*)(wrow + 65536 + 16 * 2048 + swz);
                acc0 = __builtin_amdgcn_mfma_f32_16x16x32_bf16(a0h, bhi, acc0, 0, 0, 0); acc1 = __builtin_amdgcn_mfma_f32_16x16x32_bf16(a1h, bhi, acc1, 0, 0, 0);
                acc0 = __builtin_amdgcn_mfma_f32_16x16x32_bf16(a0l, bhi, acc0, 0, 0, 0); acc1 = __builtin_amdgcn_mfma_f32_16x16x32_bf16(a1l, bhi, acc1, 0, 0, 0);
                acc0 = __builtin_amdgcn_mfma_f32_16x16x32_bf16(a0h, blo, acc0, 0, 0, 0); acc1 = __builtin_amdgcn_mfma_f32_16x16x32_bf16(a1h, blo, acc1, 0, 0, 0);
                if (s8 & 1) asm volatile("" ::: "memory");
            }
        }
        float lg[8]; int le[8];
#pragma unroll
        for (int i = 0; i < 4; ++i) { le[i] = 4 * kg + i; le[4 + i] = 16 + 4 * kg + i; lg[i] = acc0[i] + rb[4 * kg + i]; lg[4 + i] = acc1[i] + rb[16 + 4 * kg + i]; }
        float tv[4]; int te[4];
#pragma unroll
        for (int k = 0; k < 4; ++k) {
            float bv = lg[0]; int be = le[0];
#pragma unroll
            for (int i = 1; i < 8; ++i) best2(bv, be, lg[i], le[i]);
            { const auto rv = __builtin_amdgcn_permlane16_swap(__float_as_uint(bv), __float_as_uint(bv), false, false); const auto re = __builtin_amdgcn_permlane16_swap((unsigned)be, (unsigned)be, false, false);
              bv = __uint_as_float(rv[0]); be = (int)re[0]; best2(bv, be, __uint_as_float(rv[1]), (int)re[1]); }
            { const auto rv = __builtin_amdgcn_permlane32_swap(__float_as_uint(bv), __float_as_uint(bv), false, false); const auto re = __builtin_amdgcn_permlane32_swap((unsigned)be, (unsigned)be, false, false);
              bv = __uint_as_float(rv[0]); be = (int)re[0]; best2(bv, be, __uint_as_float(rv[1]), (int)re[1]); }
            tv[k] = bv; te[k] = be;
#pragma unroll
            for (int i = 0; i < 8; ++i) lg[i] = (le[i] == be) ? -INFINITY : lg[i];
        }
        const float e1 = __expf(tv[1] - tv[0]), e2 = __expf(tv[2] - tv[0]), e3 = __expf(tv[3] - tv[0]), inv = 1.0f / (1.0f + e1 + e2 + e3);
        { const int e = kg == 0 ? te[0] : kg == 1 ? te[1] : kg == 2 ? te[2] : te[3]; const float gt = (kg == 0 ? 1.0f : kg == 1 ? e1 : kg == 2 ? e2 : e3) * inv;
          const unsigned lpos = atomicAdd((unsigned*)(hist + e), 1u);
          const int a = m * 4 + kg; tok_e[a] = e | (int)(lpos << 8); gates[a] = gt; }
    }
    __syncthreads();
    if (tid < 32) wg_hist[vcu * 32 + tid] = (int)hist[tid];
}
__device__ __forceinline__ void p_scatter(const bf16* H2, const int* tok_e, const float* gates, const int* wg_hist, bf16* xs, int* row_asg, float* row_gate, int* row_tok, int* meta,
                                          LAS unsigned char* lds, int vcu, int G, int tid, int wave, int lane) {
    LAS int* sm = (LAS int*)lds;
    { const int e = tid & 31, part = tid >> 5; int p = 0, s = 0;
      for (int w = part * 16; w < part * 16 + 16; ++w) { if (w < G) { const int h = wg_hist[w * 32 + e]; s += h; if (w < vcu) p += h; } }
      sm[part * 32 + e] = p; sm[512 + part * 32 + e] = s; }
    __syncthreads();
    if (tid < 32) { int p = 0, s = 0;
#pragma unroll
        for (int q = 0; q < 16; ++q) { p += sm[q * 32 + tid]; s += sm[512 + q * 32 + tid]; }
        sm[1024 + tid] = p; sm[1056 + tid] = s; }
    __syncthreads();
    if (tid == 0) { int us = 0; for (int e = 0; e < NE; ++e) { sm[1120 + e] = us; sm[1088 + e] = us * 256; us += (sm[1056 + e] + 255) >> 8; } sm[1120 + NE] = us; }
    __syncthreads();
    if (vcu == 0 && tid <= NE) meta[tid] = sm[1120 + tid];
    const int gw = vcu * NWAVES + wave, NGW = G * NWAVES;
    for (int e = vcu; e < NE; e += G) { const int r0 = sm[1088 + e] + sm[1056 + e], r1 = sm[1088 + e] + (((sm[1056 + e] + 255) >> 8) << 8);
#if MOE_FP8 && MOE_GATHER
        for (int r = r0 + wave; r < r1; r += NWAVES) { if (lane == 0) row_tok[r] = 0;
#elif MOE_FP8
        for (int r = r0 + wave; r < r1; r += NWAVES) { v4u z = {0u, 0u, 0u, 0u}; *(v4u*)((unsigned char*)xs + (size_t)r * D + 16 * lane) = z;
#else
        for (int r = r0 + wave; r < r1; r += NWAVES) { v4u z = {0u, 0u, 0u, 0u}; *(v4u*)(xs + (size_t)r * D + 8 * lane) = z; *(v4u*)(xs + (size_t)r * D + 512 + 8 * lane) = z;
#endif
            if (lane == 0) { row_asg[r] = -1; row_gate[r] = 0.f; } } }
#if MOE_FP8 && MOE_GATHER
#if ROUTER_MFMA
    for (int task = gw; task < T / 16; task += NGW) { const int a = task * 64 + lane;
        const int te = tok_e[a], e = te & 31, lpos = te >> 8; const int dest = sm[1088 + e] + sm[1024 + e] + lpos;
        row_asg[dest] = a; row_gate[dest] = gates[a]; row_tok[dest] = a >> 2; }
#else
    { const int grp = gw + (lane >> 4) * NGW;
      if (grp < T / 4) { const int a = grp * 16 + (lane & 15); const int te = tok_e[a], e = te & 31, lpos = te >> 8; const int dest = sm[1088 + e] + sm[1024 + e] + lpos;
          row_asg[dest] = a; row_gate[dest] = gates[a]; row_tok[dest] = a >> 2; } }
    static_assert(T / 4 == 4 * 256 * NWAVES, "one pass: 4 token groups per wave on the 256-workgroup grid");
#endif
}
#elif MOE_FP8
    typedef int v4i __attribute__((ext_vector_type(4)));
    v4u nrow[4]; v4i nte[4]; f32x4 ngt[4];
    if (gw < T / 4) {
#pragma unroll
        for (int tt = 0; tt < 4; ++tt) { const int m = gw * 4 + tt; nrow[tt] = *(const v4u*)((const unsigned char*)H2 + (size_t)m * D + 16 * lane); nte[tt] = *(const v4i*)(tok_e + m * 4); ngt[tt] = *(const f32x4*)(gates + m * 4); } }
    for (int grp = gw; grp < T / 4; grp += NGW) {
        v4u crow[4]; v4i cte[4]; f32x4 cgt[4];
#pragma unroll
        for (int tt = 0; tt < 4; ++tt) { crow[tt] = nrow[tt]; cte[tt] = nte[tt]; cgt[tt] = ngt[tt]; }
        if (grp + NGW < T / 4) {
#pragma unroll
            for (int tt = 0; tt < 4; ++tt) { const int m = (grp + NGW) * 4 + tt; nrow[tt] = *(const v4u*)((const unsigned char*)H2 + (size_t)m * D + 16 * lane); nte[tt] = *(const v4i*)(tok_e + m * 4); ngt[tt] = *(const f32x4*)(gates + m * 4); } }
#pragma unroll
        for (int tt = 0; tt < 4; ++tt) { const int m = grp * 4 + tt;
#pragma unroll
            for (int k = 0; k < 4; ++k) { const int te = cte[tt][k], e = te & 31, lpos = te >> 8; const int dest = sm[1088 + e] + sm[1024 + e] + lpos;
                *(v4u*)((unsigned char*)xs + (size_t)dest * D + 16 * lane) = crow[tt];
                if (lane == 0) { row_asg[dest] = m * 4 + k; row_gate[dest] = cgt[tt][k]; } } }
    }
}
#else
    for (int grp = gw; grp < T / 4; grp += NGW) {
#pragma unroll
        for (int tt = 0; tt < 4; ++tt) { const int m = grp * 4 + tt;
#if MOE_FP8
            const v4u r0 = *(const v4u*)((const unsigned char*)H2 + (size_t)m * D + 16 * lane);
#else
            const v4u r0 = *(const v4u*)(H2 + (size_t)m * D + 8 * lane), r1 = *(const v4u*)(H2 + (size_t)m * D + 512 + 8 * lane);
#endif
#pragma unroll
            for (int k = 0; k < 4; ++k) { const int te = tok_e[m * 4 + k], e = te & 31, lpos = te >> 8; const int dest = sm[1088 + e] + sm[1024 + e] + lpos;
#if MOE_FP8
                *(v4u*)((unsigned char*)xs + (size_t)dest * D + 16 * lane) = r0;
#else
                *(v4u*)(xs + (size_t)dest * D + 8 * lane) = r0; *(v4u*)(xs + (size_t)dest * D + 512 + 8 * lane) = r1;
#endif
                if (lane == 0) { row_asg[dest] = m * 4 + k; row_gate[dest] = gates[m * 4 + k]; } } }
    }
}
#endif
__device__ __forceinline__ int moe_table(const int* meta, LAS int* ru2e, int tid) {
    __syncthreads();
    if (tid < NE) { const int u0 = meta[tid], u1 = meta[tid + 1]; for (int u = u0; u < u1; ++u) ru2e[u] = tid; }
    const int nru = meta[NE];
    __syncthreads();
    return __builtin_amdgcn_readfirstlane(nru);
}
#if YK_FP8
typedef unsigned yk_t;
#define YK_LOAD(m, k, c) (*(const unsigned*)((const unsigned char*)yk + ((size_t)(m) * 4 + (k)) * D + (c)))
#else
typedef u32x2 yk_t;
#define YK_LOAD(m, k, c) (*(const u32x2*)(yk + ((size_t)(m) * 4 + (k)) * D + (c)))
#endif
template <int LAYER> __device__ __forceinline__ void p_final(bf16* X, const bf16* Sin, const float* lng0, const float* lnb0, const bf16* yk, const float* lng, const float* lnb, const float* modl, const float* modn, bf16* hq, unsigned char* x8, float* out,
                                                               int vcu, int G, int wave, int lane) {
    const int gw = vcu * NWAVES + wave, NGW = G * NWAVES, RPW = (T + NGW - 1) / NGW;
    const int m0 = gw * RPW, m1 = (m0 + RPW) < T ? (m0 + RPW) : T;
    if (m0 < m1) {
    yk_t ny[4][4]; u32x2 nxw[4];
#pragma unroll
    for (int j = 0; j < 4; ++j) { const int c = 256 * j + 4 * lane; nxw[j] = *(const u32x2*)((FINAL_FROM_S ? Sin : X) + (size_t)m0 * D + c);
#pragma unroll
        for (int k = 0; k < 4; ++k) ny[j][k] = YK_LOAD(m0, k, c); }
    f32x4 Lg0[4], Lb0[4], Lg[4], Lb[4], G2[4], SC[4], SH[4];
#pragma unroll
    for (int j = 0; j < 4; ++j) { const int c = 256 * j + 4 * lane; Lg0[j] = *(const f32x4*)(lng0 + c); Lb0[j] = *(const f32x4*)(lnb0 + c); Lg[j] = *(const f32x4*)(lng + c); Lb[j] = *(const f32x4*)(lnb + c); }
    int bcur = -1;
    for (int m = m0; m < m1; ++m) {
        const int b = m >> 11;
        if (b != bcur) { bcur = b; const float* g2 = modl + (size_t)b * 6144 + 5 * 1024; const float* sh = modn + (size_t)b * 6144;
#pragma unroll
            for (int j = 0; j < 4; ++j) { const int c = 256 * j + 4 * lane; G2[j] = *(const f32x4*)(g2 + c) + 1.0f;
                if (LAYER == 0) { SC[j] = *(const f32x4*)(sh + 1024 + c) + 1.0f; SH[j] = *(const f32x4*)(sh + c); } } }
        yk_t cy[4][4]; u32x2 cxw[4];
#pragma unroll
        for (int j = 0; j < 4; ++j) { cxw[j] = nxw[j];
#pragma unroll
            for (int k = 0; k < 4; ++k) cy[j][k] = ny[j][k]; }
        if (m + 1 < m1) {
#pragma unroll
            for (int j = 0; j < 4; ++j) { const int c = 256 * j + 4 * lane; nxw[j] = *(const u32x2*)((FINAL_FROM_S ? Sin : X) + (size_t)(m + 1) * D + c);
#pragma unroll
                for (int k = 0; k < 4; ++k) ny[j][k] = YK_LOAD(m + 1, k, c); } }
        f32x4 x1v[4];
#pragma unroll
        for (int j = 0; j < 4; ++j) { const u32x2 xw = cxw[j]; x1v[j] = (f32x4){bf_lo(xw.x), bf_hi(xw.x), bf_lo(xw.y), bf_hi(xw.y)}; }
#if FINAL_FROM_S
        { float s0 = 0.f;
#pragma unroll
          for (int j = 0; j < 4; ++j) s0 += (x1v[j][0] + x1v[j][1]) + (x1v[j][2] + x1v[j][3]);
          const float mean0 = wave_sum(s0) * (1.0f / D); float q0 = 0.f;
#pragma unroll
          for (int j = 0; j < 4; ++j) { x1v[j] = x1v[j] - mean0; q0 += (x1v[j][0] * x1v[j][0] + x1v[j][1] * x1v[j][1]) + (x1v[j][2] * x1v[j][2] + x1v[j][3] * x1v[j][3]); }
          const float rstd0 = 1.0f / sqrtf(wave_sum(q0) * (1.0f / D) + LN_EPS);
#pragma unroll
          for (int j = 0; j < 4; ++j) x1v[j] = x1v[j] * rstd0 * Lg0[j] + Lb0[j]; }
#endif
        f32x4 v[4]; float s = 0.f;
#pragma unroll
        for (int j = 0; j < 4; ++j) {
            f32x4 y = {0.f, 0.f, 0.f, 0.f};
#pragma unroll
            for (int k = 0; k < 4; ++k) {
#if YK_FP8
                const unsigned w = cy[j][k]; const f32x2_t p0 = __builtin_amdgcn_cvt_pk_f32_fp8((int)w, false), p1 = __builtin_amdgcn_cvt_pk_f32_fp8((int)w, true); y[0] += p0.x; y[1] += p0.y; y[2] += p1.x; y[3] += p1.y;
#else
                const u32x2 w = cy[j][k]; y[0] += bf_lo(w.x); y[1] += bf_hi(w.x); y[2] += bf_lo(w.y); y[3] += bf_hi(w.y);
#endif
            }
#if YK_FP8
            y = y * (1.0f / pg8::YK_S);
#endif
            v[j] = x1v[j] * ALPHA_DN + G2[j] * y;
            s += (v[j][0] + v[j][1]) + (v[j][2] + v[j][3]); }
        const float mean = wave_sum(s) * (1.0f / D); float q = 0.f;
#pragma unroll
        for (int j = 0; j < 4; ++j) { v[j] = v[j] - mean; q += (v[j][0] * v[j][0] + v[j][1] * v[j][1]) + (v[j][2] * v[j][2] + v[j][3] * v[j][3]); }
        const float rstd = 1.0f / sqrtf(wave_sum(q) * (1.0f / D) + LN_EPS);
#pragma unroll
        for (int j = 0; j < 4; ++j) { const int c = 256 * j + 4 * lane;
            const f32x4 x2 = v[j] * rstd * Lg[j] + Lb[j];
            if (LAYER == 0) {
                u32x2 w; w.x = pkbf(x2[0], x2[1]); w.y = pkbf(x2[2], x2[3]); pg8::st8(X + (size_t)m * D + c, w);
                const f32x4 h = x2 * SC[j] + SH[j];
#if DENSE8_QKV
                pg8::st4(x8 + (size_t)m * D + c, pg8::pk4_fp8(x2[0] * DENSE8_A_S, x2[1] * DENSE8_A_S, x2[2] * DENSE8_A_S, x2[3] * DENSE8_A_S));
                pg8::st4((unsigned char*)hq + (size_t)m * D + c, pg8::pk4_fp8(h[0] * DENSE8_A_S, h[1] * DENSE8_A_S, h[2] * DENSE8_A_S, h[3] * DENSE8_A_S));
#else
                u32x2 w2; w2.x = pkbf(h[0], h[1]); w2.y = pkbf(h[2], h[3]); pg8::st8(hq + (size_t)m * D + c, w2);
#endif
            } else pg8::st16_plain(out + (size_t)m * D + c, __builtin_bit_cast(pg8::u32x4, x2));
        }
    }
    }
}
__device__ __forceinline__ int crow(int r, int hi) { return (r & 3) + 8 * (r >> 2) + 4 * hi; }
#define MFMA32(a, b, c) __builtin_amdgcn_mfma_f32_32x32x16_bf16((a), (b), (c), 0, 0, 0)
__device__ __forceinline__ bf16x8 pack8(const f32x16& x, int s) {
    v4u p; p.x = pkbf(x[8 * s], x[8 * s + 1]); p.y = pkbf(x[8 * s + 2], x[8 * s + 3]); p.z = pkbf(x[8 * s + 4], x[8 * s + 5]); p.w = pkbf(x[8 * s + 6], x[8 * s + 7]);
    return __builtin_bit_cast(bf16x8, p);
}
template <bool DIAG, bool SKIPHI = false, bool MASKLO = DIAG> __device__ __forceinline__ void attn_tile(const LAS unsigned char* Ks, const LAS unsigned char* Vs, const bf16x8 (&qr)[4], const bf16x8& ones, const bf16x8& Ua, const bf16x8& Ub,
                                                                f32x16 (&o)[2], float& R, int kv0, int qpos, int r, int h) {
    constexpr int KP = 144, VP = 136;
    const f32x16 zero = {};
    bf16x8 pa[4];
    f32x16 T1;
    if constexpr (SKIPHI) { T1 = zero; pa[2] = bf16x8{}; pa[3] = bf16x8{}; }
    else
    { f32x16 p1 = zero;
#pragma unroll
      for (int s = 0; s < 4; ++s) { const bf16x8 k1 = *(const LAS bf16x8*)(Ks + (32 + r) * KP + (16 * s + 8 * h) * 2); p1 = MFMA32(k1, qr[s], p1); }
      f32x16 L1;
#pragma unroll
      for (int i = 0; i < 16; ++i) { const float z = p1[i]; float L = -__builtin_amdgcn_logf(1.0f + __builtin_amdgcn_exp2f(__builtin_amdgcn_fmed3f(z, -1.0e30f, 100.0f)));
          if (DIAG) L = (kv0 + 32 + crow(i, h) < qpos) ? L : 0.f; L1[i] = L; p1[i] = (z + R) + L; }
      const bf16x8 l1a = pack8(L1, 0), l1b = pack8(L1, 1);
      T1 = MFMA32(ones, l1a, zero); T1 = MFMA32(ones, l1b, T1);
      f32x16 S1 = MFMA32(Ua, l1a, zero); S1 = MFMA32(Ub, l1b, S1);
#pragma unroll
      for (int i = 0; i < 16; ++i) { float a1 = __builtin_amdgcn_exp2f(p1[i] + S1[i]); if (DIAG) a1 = (kv0 + 32 + crow(i, h) < qpos) ? a1 : 0.f; p1[i] = a1; }
      pa[2] = pack8(p1, 0); pa[3] = pack8(p1, 1); }
    __builtin_amdgcn_sched_barrier(0);
    bool lo_dead = false;
#if ATT_MIDEXIT
    if constexpr (!DIAG) lo_dead = __all(R + T1[0] < -150.0f) != 0;
#endif
    if (lo_dead) { R += T1[0]; }
    else
    { f32x16 p0 = zero;
#pragma unroll
      for (int s = 0; s < 4; ++s) { const bf16x8 k0 = *(const LAS bf16x8*)(Ks + r * KP + (16 * s + 8 * h) * 2); p0 = MFMA32(k0, qr[s], p0); }
      f32x16 L0;
#pragma unroll
      for (int i = 0; i < 16; ++i) { const float z = p0[i]; float L = -__builtin_amdgcn_logf(1.0f + __builtin_amdgcn_exp2f(__builtin_amdgcn_fmed3f(z, -1.0e30f, 100.0f)));
          if (MASKLO) L = (kv0 + crow(i, h) < qpos) ? L : 0.f; L0[i] = L; p0[i] = (z + R) + L; }
      const bf16x8 l0a = pack8(L0, 0), l0b = pack8(L0, 1);
      f32x16 S0 = MFMA32(Ua, l0a, T1); S0 = MFMA32(Ub, l0b, S0);
      { f32x16 Rn = MFMA32(ones, l0a, T1); Rn = MFMA32(ones, l0b, Rn); R += Rn[0]; }
#pragma unroll
      for (int i = 0; i < 16; ++i) { float a0 = __builtin_amdgcn_exp2f(p0[i] + S0[i]); if (MASKLO) a0 = (kv0 + crow(i, h) < qpos) ? a0 : 0.f; p0[i] = a0; }
      pa[0] = pack8(p0, 0); pa[1] = pack8(p0, 1); }
    __builtin_amdgcn_sched_barrier(0);
#pragma unroll
    for (int dh = 0; dh < 2; ++dh)
#pragma unroll
        for (int hf = 0; hf < 2; ++hf)
#pragma unroll
            for (int c = 0; c < 2; ++c) { if (SKIPHI && hf == 1) continue;
                if (lo_dead && hf == 0) continue;
                const LAS unsigned char* ap = Vs + (32 * dh + r) * VP + (32 * hf + 16 * c + 4 * h) * 2;
                const s16x4 lo = *(const LAS s16x4*)ap, hi = *(const LAS s16x4*)(ap + 16);
                const bf16x8 vf = __builtin_shufflevector(lo, hi, 0, 1, 2, 3, 4, 5, 6, 7);
                o[dh] = MFMA32(pa[2 * hf + c], vf, o[dh]); }
}
#ifndef ATT_WIDE_STORE
#define ATT_WIDE_STORE 1
#endif
#ifndef ATT_MIDEXIT
#define ATT_MIDEXIT 1
#endif
#ifndef ATT_QPREF
#define ATT_QPREF 0
#endif
constexpr int ATT_WIN = 7, ATT_TILE_B = 64 * 144 + 64 * 136;
static_assert(ATT_WIN * ATT_TILE_B <= RING_BYTES, "attention window fits the ring region");
__device__ __forceinline__ void attn_stage7(const bf16* kb, const bf16* vb, LAS unsigned char* lds, int lo, int hi, int srow, int sch) {
    constexpr int KP = 144, VP = 136;
    v4u kreg[ATT_WIN], vreg[ATT_WIN];
#pragma unroll
    for (int i = 0; i < ATT_WIN; ++i) { const int t = (lo + i) < hi ? (lo + i) : hi; kreg[i] = *(const v4u*)(kb + (size_t)t * 64 * D); vreg[i] = *(const v4u*)(vb + t * 64); }
#pragma unroll
    for (int i = 0; i < ATT_WIN; ++i) { const int t = (lo + i) < hi ? (lo + i) : hi; LAS unsigned char* sl = lds + (t % ATT_WIN) * ATT_TILE_B;
        *(LAS v4u*)(sl + srow * KP + sch * 16) = kreg[i];
        { u32x2 a2 = {vreg[i].x, vreg[i].y}, c2 = {vreg[i].z, vreg[i].w}; *(LAS u32x2*)(sl + 64 * KP + srow * VP + sch * 16) = a2; *(LAS u32x2*)(sl + 64 * KP + srow * VP + sch * 16 + 8) = c2; } }
}
__device__ __forceinline__ void p_attn(const bf16* Q, const bf16* K, const bf16* VT, bf16* O, LAS unsigned char* lds, LAS unsigned* donecnt, int vcu, int G, int tid, int wave, int lane) {
    constexpr int KP = 144, VP = 136;
    const int r = lane & 31, h = lane >> 5;
    bf16x8 ones, Ua, Ub;
#pragma unroll
    for (int j = 0; j < 8; ++j) { ones[j] = (short)0x3F80; const int ka = 8 * (j >> 2) + 4 * h + (j & 3), kb = 16 + ka; Ua[j] = (ka > r) ? (short)0x3F80 : (short)0; Ub[j] = (kb > r) ? (short)0x3F80 : (short)0; }
    const int srow = tid >> 3, sch = tid & 7;
    for (int bh = vcu; bh < NBATCH * NHEAD; bh += G) {
        const int b = bh >> 4, hh = bh & 15; const size_t rowbase = (size_t)b * SEQ;
        const bf16* kb = K + (rowbase + srow) * D + hh * HDIM + 8 * sch; const bf16* vb = VT + (size_t)(hh * HDIM + srow) * T + rowbase + 8 * sch;
        __syncthreads();
        attn_stage7(kb, vb, lds, 0, 3, srow, sch);
#if ATT_QPREF
        bf16x8 qn[4];
#endif
        for (int qb = 0; qb < SEQ / 256; ++qb) {
            const int q0 = qb * 256, qw = q0 + 32 * (wave < 4 ? wave : (wave ^ 1));
            const bf16* qp = Q + (rowbase + qw + r) * D + hh * HDIM + 8 * h;
            bf16x8 qr[4];
#if ATT_QPREF
            if (qb == 0) {
#pragma unroll
                for (int s = 0; s < 4; ++s) qr[s] = *(const bf16x8*)(qp + 16 * s); }
            else {
#pragma unroll
                for (int s = 0; s < 4; ++s) qr[s] = qn[s]; }
#else
#pragma unroll
            for (int s = 0; s < 4; ++s) qr[s] = *(const bf16x8*)(qp + 16 * s);
#endif
            f32x16 o[2]; o[0] = f32x16{}; o[1] = f32x16{}; float Rv = 0.f;
            int jt = (qw + 30) >> 6;
            bool done = false, marked = false, clobbered = false;
            v4u pk[4], pv[4]; const bool has_next = qb + 1 < SEQ / 256;
            if (has_next) {
#pragma unroll
                for (int i = 0; i < 4; ++i) { const int t = 4 * qb + 4 + i; pk[i] = *(const v4u*)(kb + (size_t)t * 64 * D); pv[i] = *(const v4u*)(vb + t * 64); }
#if ATT_QPREF
#pragma unroll
                for (int s = 0; s < 4; ++s) qn[s] = *(const bf16x8*)(qp + (size_t)256 * D + 16 * s);
#endif
            }
            LAS unsigned* dc = donecnt + (qb & 1);
            for (int win_hi = 4 * qb + 3; ; ) {
                const int win_lo = (win_hi - (ATT_WIN - 1)) > 0 ? (win_hi - (ATT_WIN - 1)) : 0;
                __syncthreads();
                if (tid == 0) donecnt[(qb & 1) ^ 1] = 0u;
                for (; jt >= win_lo && !done; --jt) {
                    const LAS unsigned char* Ks = lds + (jt % ATT_WIN) * ATT_TILE_B; const LAS unsigned char* Vs = Ks + 64 * KP;
                    const int kv0 = 64 * jt;
                    if (kv0 >= qw) attn_tile<true, true>(Ks, Vs, qr, ones, Ua, Ub, o, Rv, kv0, qw + r, r, h);
                    else if (kv0 + 63 >= qw) attn_tile<true, false, false>(Ks, Vs, qr, ones, Ua, Ub, o, Rv, kv0, qw + r, r, h);
                    else attn_tile<false>(Ks, Vs, qr, ones, Ua, Ub, o, Rv, kv0, qw + r, r, h);
                    done = __all(Rv < -150.0f) != 0;
                }
                if (jt < 0) done = true;
                if (done && !marked) { marked = true; if (lane == 0) atomicAdd((unsigned*)dc, 1u); }
                __syncthreads();
                if (*dc == (unsigned)NWAVES) break;
                win_hi = win_lo - 1; clobbered = true;
                attn_stage7(kb, vb, lds, (win_hi - (ATT_WIN - 1)) > 0 ? (win_hi - (ATT_WIN - 1)) : 0, win_hi, srow, sch);
            }
#if DENSE8_P12 && ATT_WIDE_STORE
            { const int jq = lane & 3; const unsigned sel1 = (jq & 1) ? 0x03070105u : 0x06020400u, sel2 = (jq & 2) ? 0x03020706u : 0x05040100u;
              unsigned char* ob = (unsigned char*)O + (rowbase + qw + jq + 4 * h) * D + hh * HDIM + 4 * (r >> 2);
#pragma unroll
              for (int dh = 0; dh < 2; ++dh)
#pragma unroll
                for (int g = 0; g < 4; ++g) {
                    const unsigned P = pg8::pk4_fp8(o[dh][4 * g] * DENSE8_A_S, o[dh][4 * g + 1] * DENSE8_A_S, o[dh][4 * g + 2] * DENSE8_A_S, o[dh][4 * g + 3] * DENSE8_A_S);
                    const unsigned X = (unsigned)dppi<0xB1>((int)P), A = __builtin_amdgcn_perm(X, P, sel1);
                    const unsigned Y = (unsigned)dppi<0x4E>((int)A), Q = __builtin_amdgcn_perm(Y, A, sel2);
                    pg8::st4(ob + (size_t)(8 * g) * D + 32 * dh, Q); } }
#else
#pragma unroll
            for (int dh = 0; dh < 2; ++dh)
#pragma unroll
                for (int i = 0; i < 16; ++i) {
#if DENSE8_P12
                    const float ov = pg8::clamp448(o[dh][i] * DENSE8_A_S); const unsigned w8 = __builtin_amdgcn_cvt_pk_fp8_f32(ov, ov, 0u, false);
                    pg8::st1((unsigned char*)O + (rowbase + qw + crow(i, h)) * D + hh * HDIM + 32 * dh + r, (unsigned char)w8); }
#else
                    const unsigned w = pkbf(o[dh][i], 0.f); O[(rowbase + qw + crow(i, h)) * D + hh * HDIM + 32 * dh + r] = (bf16)(w & 0xffffu); }
#endif
#endif
            if (has_next) {
                if (!clobbered) {
#pragma unroll
                    for (int i = 0; i < 4; ++i) { const int t = 4 * qb + 4 + i; LAS unsigned char* sl = lds + (t % ATT_WIN) * ATT_TILE_B;
                        *(LAS v4u*)(sl + srow * KP + sch * 16) = pk[i];
                        { u32x2 a2 = {pv[i].x, pv[i].y}, c2 = {pv[i].z, pv[i].w}; *(LAS u32x2*)(sl + 64 * KP + srow * VP + sch * 16) = a2; *(LAS u32x2*)(sl + 64 * KP + srow * VP + sch * 16 + 8) = c2; } }
                } else attn_stage7(kb, vb, lds, 4 * qb + 1, 4 * qb + 7, srow, sch);
            }
        }
    }
}

#ifndef MOE_ALIGN
#define MOE_ALIGN true
#endif
#ifndef MK_PER_PHASE
#define MK_PER_PHASE 0
#endif
constexpr int N_PHASES = 18;
struct Args { const float* in[23]; float* out; unsigned char* ws; int ph_lo, ph_hi; };
static_assert(sizeof(Args) == 23 * 8 + 8 + 8 + 8, "Args has no padding bytes");

__global__ void __launch_bounds__(NTHREADS, 2) yoco_fwd(Args args) {
    extern __shared__ __attribute__((aligned(16))) unsigned char lds_raw[];
    LAS unsigned char* lds = (LAS unsigned char*)lds_raw;
    const int G = gridDim.x; const int bx = blockIdx.x; const int vcu = (G % 8 == 0) ? (bx % 8) * (G / 8) + bx / 8 : bx;
    gu32* ctl = (gu32*)(args.ws + WS_CTL);
    for (int u = threadIdx.x; u < (LDS_BYTES - LDSCTL_OFF) / 4; u += NTHREADS) ((LAS unsigned*)(lds + LDSCTL_OFF))[u] = 0u;
    __syncthreads();
    XcdBarrier bar; bar.bar = (unsigned*)(ctl + CW_BAR); bar.x = 0; bar.st = nullptr;
    if (!MK_PER_PHASE) bar = xcd_barrier_post((unsigned*)(ctl + CW_BAR), (volatile LAS unsigned*)(lds + LDSCTL_OFF));
    LAS unsigned* hist = (LAS unsigned*)(lds + LDSCTL_OFF + 64);
    LAS int* ru2e = (LAS int*)(lds + LDSCTL_OFF + 256);
    const int lo = args.ph_lo, hi = args.ph_hi;
#define LAUNDER() int tid = threadIdx.x; asm volatile("" : "+v"(tid)); const int lane = tid & 63, wave = __builtin_amdgcn_readfirstlane(tid >> 6); (void)lane; (void)wave
#ifndef PHASE_MASK
#define PHASE_MASK 0x3ffff
#endif
#define IN(k) ((((PHASE_MASK) >> (k)) & 1) && lo <= (k) && (k) < hi)
#ifndef REPEAT_MASK
#define REPEAT_MASK 0
#endif
#define REPEAT(kc) _Pragma("unroll") for (int rep_ = 0; rep_ < 1 + (((REPEAT_MASK) >> (kc)) & 1); (__syncthreads(), ++rep_))
#define REPEAT_L1(kc) _Pragma("unroll") for (int rep_ = 0; rep_ < 1 + ((((REPEAT_MASK) >> (kc)) & 1) && l == 1); (__syncthreads(), ++rep_))
#if defined(PROBE_DOUBLE_BARRIER)
#define SEAM(k) do { if (IN(k) && IN((k) + 1)) { int nb_ = 2; asm volatile("" : "+s"(nb_)); for (int r_ = 0; r_ < nb_; ++r_) xcd_barrier(bar); } } while (0)
#else
#define SEAM(k) do { if (IN(k) && IN((k) + 1)) xcd_barrier(bar); } while (0)
#endif

#define KIN(i) ((const float*)karg(8u * (unsigned)(i)))
#define WSP(type, off) ((type*)((unsigned char*)karg(192u) + (off)))
#define xin KIN(0)
#define cin KIN(1)
#define ada_w KIN(2)
#define ada_b KIN(3)
#define ln_g KIN(4)
#define ln_b KIN(5)
#define cv_b1 KIN(7)
#define cv_dw KIN(8)
#define cv_db KIN(9)
#define cv_lg KIN(10)
#define cv_lb KIN(11)
#define cv_b2 KIN(13)
#define router_w KIN(17)
#define router_b KIN(18)
#define moe_b_in KIN(20)
#define moe_b_out KIN(22)
#define mod WSP(float, WS_MOD)
#define wg_hist WSP(int, WS_HIST)
#define meta WSP(int, WS_META)
#define tok_e WSP(int, WS_TOKE)
#define gates WSP(float, WS_GATE)
#define row_asg WSP(int, WS_RASG)
#define row_gate WSP(float, WS_RGATE)
#define row_tok WSP(int, WS_RTOK)
#define rwt WSP(bf16, WS_RWT)
#define w1t WSP(bf16, WS_W1T)
#define w2t WSP(bf16, WS_W2T)
#define kvt WSP(bf16, WS_KVT)
#define qt WSP(bf16, WS_QT)
#define ot WSP(bf16, WS_OT)
#define mint WSP(bf16, WS_MIN)
#define moutt WSP(bf16, WS_MOUT)
#define xs WSP(bf16, WS_RA)
#define yk WSP(bf16, WS_RA)
#define act WSP(bf16, WS_RB)
#define hA WSP(bf16, WS_RB)
#define glu WSP(bf16, WS_RB + 64 * MiB)
#define u2 WSP(bf16, WS_RB + 128 * MiB)
#define Qb WSP(bf16, WS_RB)
#define Kb WSP(bf16, WS_RB + 64 * MiB)
#define VTb WSP(bf16, WS_RB + 128 * MiB)
#define Ob WSP(bf16, WS_RB + 192 * MiB)
#define Sb WSP(bf16, WS_S)
#define Xb WSP(bf16, WS_X)
#define H2 WSP(bf16, WS_H2)
#define x2b WSP(bf16, WS_X2B)
#define hq WSP(bf16, WS_HQ)
#define d_outp ((float*)karg(184u))

#ifndef P01_FUSED
#define P01_FUSED 1
#endif
    if (IN(0)) REPEAT(0) { LAUNDER();
        p_ada(cin, ada_w, ada_b, mod, lds, vcu, G, tid, wave, lane);
#if P01_FUSED
        asm volatile("s_waitcnt vmcnt(0)" ::: "memory"); __syncthreads();
        if (tid == 0) { __builtin_amdgcn_fence(__ATOMIC_RELEASE, "agent"); asm volatile("s_waitcnt vmcnt(0)" ::: "memory");
            __hip_atomic_fetch_add((unsigned*)(ctl + CW_ADA), 1u, __ATOMIC_RELAXED, __HIP_MEMORY_SCOPE_AGENT); }
#endif
        WPtrs P{KIN(6), KIN(12), KIN(14), KIN(15), KIN(16), KIN(19), KIN(21), w1t, w2t, kvt, qt, ot, mint, moutt};
        p_convert(P, lds, vcu, G, tid);
#if ROUTER_MFMA
        p_rwt(router_w, rwt, vcu, G, tid);
#endif
    }
#if !P01_FUSED
    SEAM(0);
#endif
    if (IN(1)) REPEAT(1) { LAUNDER();
#if P01_FUSED
        if (IN(0)) {
            if (tid == 0) { unsigned sp = 0; while (__hip_atomic_load((unsigned*)(ctl + CW_ADA), __ATOMIC_RELAXED, __HIP_MEMORY_SCOPE_AGENT) < (unsigned)G) { __builtin_amdgcn_s_sleep(2); if (++sp > (1u << 22)) break; }
                __builtin_amdgcn_fence(__ATOMIC_ACQUIRE, "agent"); asm volatile("s_waitcnt vmcnt(0)" ::: "memory"); }
            __syncthreads(); }
#endif
        p_modulate(xin, mod, hA, vcu, G, wave, lane); }
    SEAM(1);
    if (IN(2)) REPEAT(2) { pg8::Gemm g{hA, w1t, DENSE8_P2 ? 512 : 1024, 0}; pg8::StaticOrder S; S.init(T, 2048, G, bx); pg8::EpiGlu<0> E{glu, cv_b1, DENSE8_P2 ? 1.0f / (DENSE8_W_S * DENSE8_A_S) : 1.0f, 1.0f, nullptr};
        pg8::gemm_phase<pg8::EpiGlu<0>, pg8::StaticOrder, true, true, DENSE8_P2 != 0>(lds + RING_OFF, g, S, E); }
    SEAM(2);
    if (IN(3)) REPEAT(3) { LAUNDER(); WPtrs P{KIN(6), KIN(12), KIN(14), KIN(15), KIN(16), KIN(19), KIN(21), w1t, w2t, kvt, qt, ot, mint, moutt};
        p_conv(glu, cv_dw, cv_db, cv_lg, cv_lb, u2, lds, vcu, G, tid, wave, lane, P); }
    SEAM(3);
    if (IN(4)) REPEAT(4) { pg8::Gemm g{u2, w2t, DENSE8_P4 ? 512 : 1024, 0}; pg8::StaticOrder S; S.init(T, 1024, G, bx); pg8::EpiResid<false> E{xin, Sb, cv_b2, mod + 2 * 1024, DENSE8_P4 ? 1.0f / (DENSE8_W_S * DENSE8_A_S) : 1.0f};
        pg8::gemm_phase<pg8::EpiResid<false>, pg8::StaticOrder, true, true, DENSE8_P4 != 0>(lds + RING_OFF, g, S, E); }
    SEAM(4);
#pragma unroll 1
    for (int l = 0; l < 2; ++l) {
        const int pb = l == 0 ? 5 : 13;
        const size_t modoff = (size_t)l * 16 * 6144;
        if (l == 1) {
            if (IN(10)) REPEAT(10) {
#if DENSE8_QKV
                constexpr float qkv_s = 1.0f / (DENSE8_W_S * DENSE8_A_S);
                { pg8::Gemm g{x2b, kvt, 512, 0}; pg8::StaticOrder S; S.init(T, 1024, G, bx); pg8::EpiBf16 E{Kb, 1024, qkv_s};
                  pg8::gemm_phase<pg8::EpiBf16, pg8::StaticOrder, true, true, true>(lds + RING_OFF, g, S, E); }
                { pg8::Gemm g{(const bf16*)((const unsigned char*)kvt + (size_t)1024 * 1024), x2b, 512, 0}; pg8::StaticOrder S; S.init(1024, T, G, bx); pg8::EpiBf16 E{VTb, T, qkv_s};
                  pg8::gemm_phase<pg8::EpiBf16, pg8::StaticOrder, true, true, true>(lds + RING_OFF, g, S, E); }
                { pg8::Gemm g{hq, qt, 512, 0}; pg8::StaticOrder S; S.init(T, 1024, G, bx); pg8::EpiBf16 E{Qb, 1024, 0.125f * LOG2E * qkv_s};
                  pg8::gemm_phase<pg8::EpiBf16, pg8::StaticOrder, true, true, true>(lds + RING_OFF, g, S, E); }
#else
                { pg8::Gemm g{Xb, kvt, 1024, 0}; pg8::StaticOrder S; S.init(T, 1024, G, bx); pg8::EpiBf16 E{Kb, 1024, 1.0f};
                  pg8::gemm_phase<pg8::EpiBf16, pg8::StaticOrder, true, true>(lds + RING_OFF, g, S, E); }
                { pg8::Gemm g{kvt + (size_t)1024 * 1024, Xb, 1024, 0}; pg8::StaticOrder S; S.init(1024, T, G, bx); pg8::EpiBf16 E{VTb, T, 1.0f};
                  pg8::gemm_phase<pg8::EpiBf16, pg8::StaticOrder, true, true>(lds + RING_OFF, g, S, E); }
                { pg8::Gemm g{hq, qt, 1024, 0}; pg8::StaticOrder S; S.init(T, 1024, G, bx); pg8::EpiBf16 E{Qb, 1024, 0.125f * LOG2E};
                  pg8::gemm_phase<pg8::EpiBf16, pg8::StaticOrder, true, true>(lds + RING_OFF, g, S, E); }
#endif
            }
            SEAM(10);
            if (IN(11)) REPEAT(11) { LAUNDER(); p_attn(Qb, Kb, VTb, Ob, lds, (LAS unsigned*)(lds + LDSCTL_OFF + 32), vcu, G, tid, wave, lane); }
            SEAM(11);
            if (IN(12)) REPEAT(12) { pg8::Gemm g{Ob, ot, DENSE8_P12 ? 512 : 1024, 0}; pg8::StaticOrder S; S.init(T, 1024, G, bx); pg8::EpiResid<true> E{Xb, Sb, nullptr, mod + modoff + 2 * 1024, DENSE8_P12 ? 1.0f / (DENSE8_W_S * DENSE8_A_S) : 1.0f};
                pg8::gemm_phase<pg8::EpiResid<true>, pg8::StaticOrder, true, true, DENSE8_P12 != 0>(lds + RING_OFF, g, S, E); }
            SEAM(12);
        }
#if ROUTER_MFMA
        if (IN(pb)) REPEAT(5) { LAUNDER(); p_router_mfma(Sb, ln_g + (size_t)(l * 2) * D, ln_b + (size_t)(l * 2) * D, mod + modoff, rwt + (size_t)l * 2 * NE * D, router_b + l * NE, Xb, H2, tok_e, gates, wg_hist, lds, hist, vcu, G, tid, wave, lane); }
#else
        if (IN(pb)) REPEAT(5) { LAUNDER(); p_router(Sb, ln_g + (size_t)(l * 2) * D, ln_b + (size_t)(l * 2) * D, mod + modoff, router_w + (size_t)l * D * NE, router_b + l * NE, Xb, H2, tok_e, gates, wg_hist, lds, hist, vcu, G, tid, wave, lane); }
#endif
        SEAM(pb);
        if (IN(pb + 1)) REPEAT(6) { LAUNDER(); p_scatter(H2, tok_e, gates, wg_hist, xs, row_asg, row_gate, row_tok, meta, lds, vcu, G, tid, wave, lane); }
        SEAM(pb + 1);
        if (IN(pb + 2)) REPEAT(7) { LAUNDER(); const int nru = moe_table(meta, ru2e, tid);
#if MOE_FP8
            pg8::MoeOrderT<MOE_HANDOFF ? 1 : 0> S; S.init(nru, 8, G, bx, ru2e, (LAS int*)(lds + LDSCTL_OFF + 3072)); S.cnt = (unsigned*)(ctl + CW_CNT + l * CNT_LAYER_WORDS); S.build(tid); __syncthreads();
            pg8::EpiGlu<2> E{act, moe_b_in + (size_t)l * NE * 2048, 1.0f / (FP8_WIN_S * FP8_ACT_S), FP8_ACT_S, (LAS float*)(lds + LDSCTL_OFF + 8192)};
#if MOE_GATHER
            pg8::Gemm g{H2, (const bf16*)((const unsigned char*)mint + (size_t)l * NE * 2048 * 1024), 512, (size_t)2048 * 1024, row_tok, (LAS int*)(lds + LDSCTL_OFF + 4096)};
            pg8::gemm_phase<pg8::EpiGlu<2>, pg8::MoeOrderT<MOE_HANDOFF ? 1 : 0>, MOE_ALIGN, true, true, true>(lds + RING_OFF, g, S, E);
            if (MOE_HANDOFF && tid == 0) (void)__hip_atomic_fetch_add((unsigned*)(ctl + CW_CNT + l * CNT_LAYER_WORDS + pg8::MoeOrderT<2>::ALLW), 1u, __ATOMIC_RELAXED, __HIP_MEMORY_SCOPE_AGENT); }
#else
            pg8::Gemm g{xs, (const bf16*)((const unsigned char*)mint + (size_t)l * NE * 2048 * 1024), 512, (size_t)2048 * 1024};
            pg8::gemm_phase<pg8::EpiGlu<2>, pg8::MoeOrder, MOE_ALIGN, true, true>(lds + RING_OFF, g, S, E); }
#endif
#else
            pg8::Gemm g{xs, mint + (size_t)l * NE * 2048 * 1024, 1024, (size_t)2048 * 1024 * 2}; pg8::MoeOrder S; S.init(nru, 8, G, bx, ru2e, (LAS int*)(lds + LDSCTL_OFF + 3072)); S.build(tid); __syncthreads();
            pg8::EpiGlu<1> E{act, moe_b_in + (size_t)l * NE * 2048, 1.0f, 1.0f, nullptr};
            pg8::gemm_phase<pg8::EpiGlu<1>, pg8::MoeOrder, true, true>(lds + RING_OFF, g, S, E); }
#endif
#if !(MOE_HANDOFF && MOE_FP8 && MOE_GATHER)
        SEAM(pb + 2);
#endif
        if (IN(pb + 3)) REPEAT(8) { LAUNDER(); const int nru = moe_table(meta, ru2e, tid);
#if MOE_FP8
            pg8::Gemm g{act, (const bf16*)((const unsigned char*)moutt + (size_t)l * NE * 1024 * 1024), 512, (size_t)1024 * 1024}; pg8::MoeOrderT<MOE_HANDOFF ? 2 : 0> S;
            int c2 = bx; if (MOE_HANDOFF && (G % 8) == 0) { const int W = G / 8, rk = bx / 8, sh = nru % W; const int rk2 = rk - sh < 0 ? rk - sh + W : rk - sh; c2 = rk2 * 8 + (bx % 8); }
            S.init(nru, 4, G, c2, ru2e, (LAS int*)(lds + LDSCTL_OFF + 3072)); S.cnt = (unsigned*)(ctl + CW_CNT + l * CNT_LAYER_WORDS); S.need = 64u; S.rot = 2 * MOE_WGM * 4;
            S.allflag = (LAS unsigned*)(lds + LDSCTL_OFF + 48); S.allneed = (unsigned)G; if (tid == 0) *S.allflag = 0xffffffffu; S.build(tid); __syncthreads();
            pg8::EpiMoeOut E{yk, moe_b_out + (size_t)l * NE * 1024, row_asg, row_gate, 1.0f / (FP8_WOUT_S * FP8_ACT_S), (LAS float*)(lds + LDSCTL_OFF + 8192)};
            pg8::gemm_phase<pg8::EpiMoeOut, pg8::MoeOrderT<MOE_HANDOFF ? 2 : 0>, MOE_ALIGN, true, true>(lds + RING_OFF, g, S, E); }
#else
            pg8::Gemm g{act, moutt + (size_t)l * NE * 1024 * 1024, 1024, (size_t)1024 * 1024 * 2}; pg8::MoeOrder S; S.init(nru, 4, G, bx, ru2e, (LAS int*)(lds + LDSCTL_OFF + 3072)); S.build(tid); __syncthreads();
            pg8::EpiMoeOut E{yk, moe_b_out + (size_t)l * NE * 1024, row_asg, row_gate, 1.0f, (LAS float*)(lds + LDSCTL_OFF + 8192)};
            pg8::gemm_phase<pg8::EpiMoeOut, pg8::MoeOrder, true, true>(lds + RING_OFF, g, S, E); }
#endif
        SEAM(pb + 3);
        if (IN(pb + 4)) REPEAT_L1(9) { LAUNDER();
            if (l == 0) p_final<0>(Xb, Sb, ln_g + (size_t)(l * 2) * D, ln_b + (size_t)(l * 2) * D, yk, ln_g + (size_t)(l * 2 + 1) * D, ln_b + (size_t)(l * 2 + 1) * D, mod + modoff, mod + (size_t)16 * 6144, hq, (unsigned char*)x2b, d_outp, vcu, G, wave, lane);
            else p_final<1>(Xb, Sb, ln_g + (size_t)(l * 2) * D, ln_b + (size_t)(l * 2) * D, yk, ln_g + (size_t)(l * 2 + 1) * D, ln_b + (size_t)(l * 2 + 1) * D, mod + modoff, mod, hq, (unsigned char*)x2b, d_outp, vcu, G, wave, lane);
        }
        if (l == 0) SEAM(9);
    }
#undef IN
#undef SEAM
}
#undef xin
#undef cin
#undef mod
#undef meta
#undef act
#undef glu
#undef gates
#undef xs
#undef yk
#undef hq
#undef ot
#undef qt
#undef u2
#undef hA

extern "C" void kernel_launch(void* const* d_in, const int* in_sizes, int n_in, void* d_out, int out_size, void* d_ws, size_t ws_size, hipStream_t stream) {
    static int grid = 0;
    if (grid == 0) {
        if (n_in != 23 || in_sizes[0] != T * D || out_size != T * D || ws_size < WS_END) { fprintf(stderr, "kernel_launch: unexpected problem: n_in %d in0 %d out %d ws %zu (need %zu); nothing launched\n", n_in, n_in > 0 ? in_sizes[0] : -1, out_size, ws_size, (size_t)WS_END); grid = -1; return; }
        int dev = 0, cus = 0, per_cu = 0;
        if (hipGetDevice(&dev) != hipSuccess || hipDeviceGetAttribute(&cus, hipDeviceAttributeMultiprocessorCount, dev) != hipSuccess) { fprintf(stderr, "kernel_launch: device query failed\n"); grid = -1; return; }
        if (hipFuncSetAttribute((const void*)yoco_fwd, hipFuncAttributeMaxDynamicSharedMemorySize, LDS_BYTES) != hipSuccess) { fprintf(stderr, "kernel_launch: hipFuncSetAttribute failed\n"); grid = -1; return; }
        if (hipOccupancyMaxActiveBlocksPerMultiprocessor(&per_cu, (const void*)yoco_fwd, NTHREADS, LDS_BYTES) != hipSuccess || per_cu < 1)
            fprintf(stderr, "kernel_launch: note: occupancy query reports %d workgroups per CU\n", per_cu);
        (void)hipGetLastError();
        grid = cus;
        if (grid % 8 != 0 || grid > 256) { fprintf(stderr, "kernel_launch: built for <= 256 CUs in 8 XCDs, got %d\n", grid); }
    }
    if (grid < 0) return;
    if (hipMemsetAsync((char*)d_ws + WS_CTL, 0, CTL_ZERO_BYTES, stream) != hipSuccess) { fprintf(stderr, "kernel_launch: memset failed\n"); return; }
    Args a; memset(&a, 0, sizeof(a));
    for (int i = 0; i < 23; ++i) a.in[i] = (const float*)d_in[i];
    a.out = (float*)d_out; a.ws = (unsigned char*)d_ws;
#if MK_PER_PHASE
    for (int p = 0; p < N_PHASES; ++p) { a.ph_lo = p; a.ph_hi = p + 1; hipLaunchKernelGGL(yoco_fwd, dim3(grid), dim3(NTHREADS), LDS_BYTES, stream, a); }
#else
    a.ph_lo = 0; a.ph_hi = N_PHASES;
    hipLaunchKernelGGL(yoco_fwd, dim3(grid), dim3(NTHREADS), LDS_BYTES, stream, a);
#endif
    const hipError_t le = hipPeekAtLastError();
    if (le != hipSuccess) fprintf(stderr, "kernel_launch: launch failed: %s\n", hipGetErrorName(le));
}
```
